# Optimizing an MI355X kernel written in HIP

```python
import jax
import jax.numpy as jnp
from jax import lax
import numpy as np


D_MODEL = 1024
BATCH = 8
SEQ = 4096
DEPTH = 1

CTX_LEN = 256
GRID_W = 64

RET_HEADS = 4
RET_DK = 128
RET_DV = 128
RET_CHUNK = 128
RET_W = RET_HEADS * RET_DV
RET_SCALE = RET_DK ** -0.5

ATT_HEADS = 8
ATT_KV_HEADS = 2
ATT_GROUP = ATT_HEADS // ATT_KV_HEADS
ATT_HD = 64
ATT_W = ATT_HEADS * ATT_HD
ATT_SCALE = ATT_HD ** -0.5
Q_BLOCK = 128

MIX_W = RET_W + ATT_W
D_FF = 4 * D_MODEL
ROPE_BASE = 10000.0
EPS = 1e-6

RQ_OFF = 0
RK_OFF = RQ_OFF + RET_HEADS * RET_DK
RV_OFF = RK_OFF + RET_HEADS * RET_DK
RG_OFF = RV_OFF + RET_W
AQ_OFF = RG_OFF + RET_W
AK_OFF = AQ_OFF + ATT_W
AV_OFF = AK_OFF + ATT_KV_HEADS * ATT_HD
D_IN = AV_OFF + ATT_KV_HEADS * ATT_HD
SPLIT_IDX = [RK_OFF, RV_OFF, RG_OFF, AQ_OFF, AK_OFF, AV_OFF]

kernel_name = "hybrid_retention_gqa_dit_layer"


def _rmsnorm(x, g):
    xf = x.astype(jnp.float32)
    y = xf * lax.rsqrt(jnp.mean(xf * xf, axis=-1, keepdims=True) + EPS)
    return (y * g.astype(jnp.float32)).astype(x.dtype)


def _modulate(h, shift, scale):
    return h * (1 + scale) + shift


def _freqs(n_pairs):
    return ROPE_BASE ** (-jnp.arange(n_pairs, dtype=jnp.float32) / n_pairs)


def _apply_rope(x, cos, sin):
    x1, x2 = jnp.split(x, 2, axis=-1)
    return jnp.concatenate([x1 * cos - x2 * sin, x1 * sin + x2 * cos], axis=-1).astype(x.dtype)


def _heads(t, n_heads):
    B, L, W = t.shape
    return t.reshape(B, L, n_heads, W // n_heads).transpose(0, 2, 1, 3)


def _retention_chunkwise(q, k, v, log_gamma, s0):
    B, H, L, dk = q.shape
    dv = v.shape[-1]
    n_chunks = L // RET_CHUNK

    def chunks(t):
        return jnp.moveaxis(t.reshape(B, H, n_chunks, RET_CHUNK, t.shape[-1]), 2, 0)

    idx = jnp.arange(RET_CHUNK, dtype=jnp.float32)
    lg = log_gamma.astype(jnp.float32)[:, None]
    rel = idx[:, None] - idx[None, :]
    intra = jnp.where(rel >= 0, jnp.exp(lg[:, :, None] * jnp.maximum(rel, 0.0)), 0.0)
    q_dec = jnp.exp(lg * (idx + 1.0))[:, :, None]
    k_dec = jnp.exp(lg * (RET_CHUNK - 1.0 - idx))[:, :, None]
    c_dec = jnp.exp(lg * RET_CHUNK)[:, :, None]

    def step(state, qkv):
        qf, kf, vf = (t.astype(jnp.float32) for t in qkv)
        scores = jnp.einsum('bhid,bhjd->bhij', qf, kf) * intra
        o = (jnp.einsum('bhij,bhjv->bhiv', scores, vf)
             + jnp.einsum('bhid,bhdv->bhiv', qf, state) * q_dec)
        state = state * c_dec + jnp.einsum('bhjd,bhjv->bhdv', kf * k_dec, vf)
        return state, o

    s_fin, o = lax.scan(step, s0, (chunks(q), chunks(k), chunks(v)))
    o = jnp.moveaxis(o, 0, 2).reshape(B, H, L, dv)
    return o, s_fin


def _retention_final_state(k, v, log_gamma):
    L = k.shape[2]
    pos = jnp.arange(L, dtype=jnp.float32)
    w = jnp.exp(log_gamma.astype(jnp.float32)[:, None] * (L - 1.0 - pos))
    return jnp.einsum('bhld,bhlv->bhdv', k.astype(jnp.float32) * w[:, :, None], v.astype(jnp.float32))


def _flip(t):
    return jnp.flip(t, axis=2)


def _bidir_retention(q, k, v, log_gamma, s0_fwd, s0_bwd):
    o_f, s_f = _retention_chunkwise(q, k, v, log_gamma[0], s0_fwd)
    o_b, s_b = _retention_chunkwise(_flip(q), _flip(k), _flip(v), log_gamma[1], s0_bwd)
    return o_f + _flip(o_b), s_f, s_b


def _ret_out(o, gate, gn_g):
    B, H, L, dv = o.shape
    mu = jnp.mean(o, axis=-1, keepdims=True)
    var = jnp.mean(jnp.square(o - mu), axis=-1, keepdims=True)
    o = ((o - mu) * lax.rsqrt(var + EPS)).transpose(0, 2, 1, 3).reshape(B, L, H * dv)
    o = o * gn_g.astype(jnp.float32)
    return (o * jax.nn.silu(gate.astype(jnp.float32))).astype(gate.dtype)


def _dense_attention(q, k, v):
    s = jnp.einsum('bqkgd,bskd->bkgqs', q, k).astype(jnp.float32) * ATT_SCALE
    p = jax.nn.softmax(s, axis=-1).astype(v.dtype)
    return jnp.einsum('bkgqs,bskd->bqkgd', p, v)


def _latent_attention(q, k_lat, v_lat, k_ctx, v_ctx):
    B, L = q.shape[:2]
    k_all = jnp.concatenate([k_ctx, k_lat], axis=1)
    v_all = jnp.concatenate([v_ctx, v_lat], axis=1)
    qb = jnp.moveaxis(q.reshape(B, L // Q_BLOCK, Q_BLOCK, ATT_KV_HEADS, ATT_GROUP, ATT_HD), 1, 0)
    o = lax.map(lambda qblk: _dense_attention(qblk, k_all, v_all), qb)
    return jnp.moveaxis(o, 0, 1).reshape(B, L, ATT_W)


def _sqrelu_mlp(h, w1, w2):
    return jnp.square(jax.nn.relu(h @ w1)) @ w2


def _layer(x, xc, c_act, cc_act, w_mod, b_mod, norm1_g, norm2_g, w_in, w_out,
           ret_log_rate, ret_gn_g, q_norm_g, k_norm_g, w_ff1, w_ff2,
           ret_cs, att_cs, ctx_out):
    B, L, _ = x.shape
    Lc = xc.shape[1]
    mod = (c_act @ w_mod + b_mod)[:, None, :]
    mod_c = (cc_act @ w_mod + b_mod)[None, None, :]
    sh1, sc1, g1, sh2, sc2, g2 = jnp.split(mod, 6, axis=-1)
    csh1, csc1, cg1, csh2, csc2, cg2 = jnp.split(mod_c, 6, axis=-1)
    log_gamma = jnp.log1p(-jnp.exp(ret_log_rate.astype(jnp.float32)))

    h = _modulate(_rmsnorm(x, norm1_g), sh1, sc1)
    hc = _modulate(_rmsnorm(xc, norm1_g), csh1, csc1)
    rq, rk, rv, rg, aq, ak, av = jnp.split(h @ w_in, SPLIT_IDX, axis=-1)
    if ctx_out:
        crq, crk, crv, crg, caq, cak, cav = jnp.split(hc @ w_in, SPLIT_IDX, axis=-1)
    else:
        crk, crv = jnp.split(hc @ w_in[:, RK_OFF:RG_OFF], 2, axis=-1)
        cak, cav = jnp.split(hc @ w_in[:, AK_OFF:D_IN], 2, axis=-1)

    crk_h = _heads(crk, RET_HEADS) * RET_SCALE
    crv_h = _heads(crv, RET_HEADS)
    if ctx_out:
        zeros = jnp.zeros((B, RET_HEADS, RET_DK, RET_DV), jnp.float32)
        ret_c, s_f, s_b = _bidir_retention(_heads(crq, RET_HEADS), crk_h, crv_h, log_gamma, zeros, zeros)
    else:
        s_f = _retention_final_state(crk_h, crv_h, log_gamma[0])
        s_b = _retention_final_state(_flip(crk_h), _flip(crv_h), log_gamma[1])
    rq_h = _apply_rope(_heads(rq, RET_HEADS), *ret_cs)
    rk_h = _apply_rope(_heads(rk, RET_HEADS), *ret_cs) * RET_SCALE
    ret, _, _ = _bidir_retention(rq_h, rk_h, _heads(rv, RET_HEADS), log_gamma, s_f, s_b)
    ret = _ret_out(ret, rg, ret_gn_g)

    q = _apply_rope(_rmsnorm(aq.reshape(B, L, ATT_HEADS, ATT_HD), q_norm_g), *att_cs)
    k = _apply_rope(_rmsnorm(ak.reshape(B, L, ATT_KV_HEADS, ATT_HD), k_norm_g), *att_cs)
    v = av.reshape(B, L, ATT_KV_HEADS, ATT_HD)
    kc = _rmsnorm(cak.reshape(B, Lc, ATT_KV_HEADS, ATT_HD), k_norm_g)
    vc = cav.reshape(B, Lc, ATT_KV_HEADS, ATT_HD)
    att = _latent_attention(q.reshape(B, L, ATT_KV_HEADS, ATT_GROUP, ATT_HD), k, v, kc, vc)

    x = x + g1 * (jnp.concatenate([ret, att], axis=-1) @ w_out)

    h2 = _modulate(_rmsnorm(x, norm2_g), sh2, sc2)
    x = x + g2 * _sqrelu_mlp(h2, w_ff1, w_ff2)

    if ctx_out:
        ret_c = _ret_out(ret_c, crg, ret_gn_g)
        qc = _rmsnorm(caq.reshape(B, Lc, ATT_KV_HEADS, ATT_GROUP, ATT_HD), q_norm_g)
        att_c = _dense_attention(qc, kc, vc).reshape(B, Lc, ATT_W)
        xc = xc + cg1 * (jnp.concatenate([ret_c, att_c], axis=-1) @ w_out)
        hc2 = _modulate(_rmsnorm(xc, norm2_g), csh2, csc2)
        xc = xc + cg2 * _sqrelu_mlp(hc2, w_ff1, w_ff2)
    return x, xc


def setup_inputs(seed: int = 0) -> dict:
    key = jax.random.key(seed)
    ks = jax.random.split(key, 17)
    f32 = jnp.float32
    nrm = lambda k, shape, s: jax.random.normal(k, shape, f32) * s
    base_rate = -(5.0 + jnp.arange(RET_HEADS, dtype=f32)) * np.float32(np.log(2.0))
    return {
        "x": nrm(ks[0], (BATCH, SEQ, D_MODEL), 1.0),
        "c": nrm(ks[1], (BATCH, D_MODEL), 1.0),
        "ctx": nrm(ks[2], (BATCH, CTX_LEN, D_MODEL), 1.0),
        "c_ctx": nrm(ks[3], (D_MODEL,), 1.0),
        "w_mod": nrm(ks[4], (DEPTH, D_MODEL, 6 * D_MODEL), 0.01),
        "b_mod": nrm(ks[5], (DEPTH, 6 * D_MODEL), 0.02),
        "norm1_g": 1.0 + nrm(ks[6], (DEPTH, D_MODEL), 0.02),
        "norm2_g": 1.0 + nrm(ks[7], (DEPTH, D_MODEL), 0.02),
        "w_in": nrm(ks[8], (DEPTH, D_MODEL, D_IN), D_MODEL ** -0.5),
        "w_out": nrm(ks[9], (DEPTH, MIX_W, D_MODEL), MIX_W ** -0.5),
        "ret_log_rate": base_rate[None, None, :] + nrm(ks[10], (DEPTH, 2, RET_HEADS), 0.05),
        "ret_gn_g": 1.0 + nrm(ks[11], (DEPTH, RET_W), 0.02),
        "q_norm_g": 1.0 + nrm(ks[12], (DEPTH, ATT_HD), 0.02),
        "k_norm_g": 1.0 + nrm(ks[13], (DEPTH, ATT_HD), 0.02),
        "w_ff1": nrm(ks[14], (DEPTH, D_MODEL, D_FF), D_MODEL ** -0.5),
        "w_ff2": nrm(ks[15], (DEPTH, D_FF, D_MODEL), D_FF ** -0.5),
        "final_norm_g": 1.0 + nrm(ks[16], (D_MODEL,), 0.02),
    }


def reference(x, c, ctx, c_ctx, w_mod, b_mod, norm1_g, norm2_g, w_in, w_out,
              ret_log_rate, ret_gn_g, q_norm_g, k_norm_g, w_ff1, w_ff2, final_norm_g):
    L = x.shape[1]
    ROWS = L // GRID_W
    t = jnp.arange(L, dtype=jnp.float32)
    ret_ang = t[:, None] * _freqs(RET_DK // 2)
    ret_cs = (jnp.cos(ret_ang), jnp.sin(ret_ang))
    row = jnp.repeat(jnp.arange(ROWS, dtype=jnp.float32), GRID_W)
    col = jnp.tile(jnp.arange(GRID_W, dtype=jnp.float32), ROWS)
    af = _freqs(ATT_HD // 4)
    att_ang = jnp.concatenate([row[:, None] * af, col[:, None] * af], axis=-1)[:, None, :]
    att_cs = (jnp.cos(att_ang), jnp.sin(att_ang))

    c_act = jax.nn.silu(c)
    cc_act = jax.nn.silu(c_ctx)
    xc = ctx
    for l in range(DEPTH):
        x, xc = _layer(x, xc, c_act, cc_act, w_mod[l], b_mod[l], norm1_g[l], norm2_g[l],
                       w_in[l], w_out[l], ret_log_rate[l], ret_gn_g[l], q_norm_g[l], k_norm_g[l],
                       w_ff1[l], w_ff2[l], ret_cs, att_cs, l < DEPTH - 1)
    return _rmsnorm(x, final_norm_g)
```

```cpp
#include <hip/hip_runtime.h>
#include <cstdio>
#include <cstdint>
namespace pg8 {
#define PG8_LAS __attribute__((address_space(3)))
typedef unsigned short bf16_t;
typedef short bf16x8 __attribute__((ext_vector_type(8)));
typedef float f32x4 __attribute__((ext_vector_type(4)));
typedef unsigned u32x4 __attribute__((ext_vector_type(4)));
constexpr int BM = 256, BK = 64, HALF = 128, HTB = HALF * BK * 2  , STAGE_BYTES = 8 * HTB, NXCD = 8, WGM = 8;

__host__ __device__ __forceinline__ int lds_byte(int r, int c) { const int st = (r >> 4) * 2 + (c >> 5), rr = r & 15, cc = c & 31, ob = rr * 64 + cc * 2; return st * 1024 + (ob ^ (((ob >> 9) & 1) << 5)); }
__host__ __device__ __forceinline__ void stage_rc(int b, int& R, int& C) { const int st = b / 1024, sb = b % 1024, swz = sb ^ (((sb >> 9) & 1) << 5); R = (st >> 1) * 16 + swz / 64; C = (st & 1) * 32 + (swz % 64) / 2; }
__host__ __device__ __forceinline__ int perm32(int rho) { const int n = rho >> 4, i = rho & 15; return 8 * (i >> 2) + 4 * n + (i & 3); }

struct Unit { int pm, pn; };
struct Gemm { const bf16_t* A; const bf16_t* Bt; int M, N, K; };

struct StaticOrder {
    int nM, nN, nwg, G, c;
    __host__ __device__ void init(int M, int N, int G_, int c_) { nM = M / BM; nN = N / BM; nwg = nM * nN; G = G_; c = c_; }
    __host__ __device__ bool next(int i, Unit& u) const {
        const long L = (long)i * G + c; if (L >= nwg) return false;
        int wgid = (int)L; { const int q = nwg / NXCD, r = nwg % NXCD, xcd = wgid % NXCD, off = wgid / NXCD; wgid = (xcd < r ? xcd * (q + 1) : r * (q + 1) + (xcd - r) * q) + off; }
        const int nig = WGM * nN, gid = wgid / nig, fm = gid * WGM, gsz = (nM - fm) < WGM ? (nM - fm) : WGM;
        u.pm = fm + ((wgid % nig) % gsz); u.pn = (wgid % nig) / gsz; return true;
    }
    __device__ __forceinline__ void a_ready(const Unit&) const {}
    __device__ __forceinline__ void done(const Unit&) const {}
};

__device__ __forceinline__ unsigned cvt_pk_bf16(float lo, float hi) { unsigned r; asm volatile("v_cvt_pk_bf16_f32 %0, %1, %2" : "=v"(r) : "v"(lo), "v"(hi)); return r; }
typedef float f32x2 __attribute__((ext_vector_type(2)));
__device__ __forceinline__ f32x2 gelu_pk(f32x2 v) {
    const f32x2 av = __builtin_elementwise_abs(v), d = av * 0.2316418882f + 1.0f;
    f32x2 t; t.x = __builtin_amdgcn_rcpf(d.x); t.y = __builtin_amdgcn_rcpf(d.y);
    f32x2 q = t * 0.5307027145f + (-0.7265760135f); q = q * t + 0.7107068705f; q = q * t + (-0.142248368f); q = q * t + 0.127414796f; q = q * t;
    const f32x2 s = (v * v) * (-0.72134752044f);
    f32x2 e; e.x = __builtin_amdgcn_exp2f(s.x); e.y = __builtin_amdgcn_exp2f(s.y);
    const f32x2 m = v * (q * e), r = v - m;
    f32x2 o; o.x = v.x < 0.f ? m.x : r.x; o.y = v.y < 0.f ? m.y : r.y; return o;
}

template <int ACT  > struct EpiBf16 {
    static constexpr bool PERM = true, AFTER_DRAIN = false; static_assert(ACT == 0 || ACT == 1, "EpiBf16: ACT is 0 (none) or 1 (gelu_pk)");
    bf16_t* O; int ldc; const float* bias; int split_cols; size_t split_stride; float scale0;
    __device__ __forceinline__ void operator()(const f32x4 (&acc)[2][2][4][2], const Unit& u, int wr, int wc, int fr, int fq) const {
        const int row0 = u.pm * BM + wr * 64 + fr; int colt = u.pn * BM; bf16_t* base = O;
        float sc = 1.f; if (split_cols) { const int t = colt / split_cols; base += (size_t)t * split_stride; colt -= t * split_cols; if (t == 0) sc = scale0; }
        const int col0 = colt + wc * 32 + 8 * fq, bcol0 = u.pn * BM + wc * 32 + 8 * fq;
        f32x4 bv[2][2];
#pragma unroll
        for (int bj = 0; bj < 2; ++bj)
#pragma unroll
            for (int n = 0; n < 2; ++n) bv[bj][n] = bias ? *(const f32x4*)(bias + bcol0 + bj * HALF + 4 * n) : (f32x4){0.f, 0.f, 0.f, 0.f};
#pragma unroll
        for (int ai = 0; ai < 2; ++ai)
#pragma unroll
            for (int m = 0; m < 4; ++m) { bf16_t* rowp = base + (size_t)(row0 + ai * HALF + m * 16) * ldc + col0;
#pragma unroll
                for (int bj = 0; bj < 2; ++bj) { f32x4 v0 = acc[ai][bj][m][0] + bv[bj][0], v1 = acc[ai][bj][m][1] + bv[bj][1];
                    if (ACT == 1) { f32x2 a = gelu_pk((f32x2){v0[0], v0[1]}), b = gelu_pk((f32x2){v0[2], v0[3]}), c = gelu_pk((f32x2){v1[0], v1[1]}), d = gelu_pk((f32x2){v1[2], v1[3]});
                        v0 = (f32x4){a.x, a.y, b.x, b.y}; v1 = (f32x4){c.x, c.y, d.x, d.y}; }
                    v0 = v0 * sc; v1 = v1 * sc; u32x4 w; w.x = cvt_pk_bf16(v0[0], v0[1]); w.y = cvt_pk_bf16(v0[2], v0[3]); w.z = cvt_pk_bf16(v1[0], v1[1]); w.w = cvt_pk_bf16(v1[2], v1[3]);
                    *(u32x4*)(rowp + bj * HALF) = w; } }
    }
};
__device__ __forceinline__ void sincos_rad(float x, float& s, float& c) {
    const float n = __builtin_rintf(x * 0.15915493667125702f);
    float fr = __builtin_fmaf(x, 0.15915493667125702f, -n);
    fr = __builtin_fmaf(x, 6.420638326565253e-09f, fr);
    s = __builtin_amdgcn_sinf(fr); c = __builtin_amdgcn_cosf(fr);
}
__device__ __forceinline__ u32x4 pack8(const f32x4 a, const f32x4 b) { u32x4 w; w.x = cvt_pk_bf16(a[0], a[1]); w.y = cvt_pk_bf16(a[2], a[3]); w.z = cvt_pk_bf16(b[0], b[1]); w.w = cvt_pk_bf16(b[2], b[3]); return w; }

struct EpiIn {
    static constexpr bool PERM = true, AFTER_DRAIN = false;
    bf16_t *RQ, *RK, *RV, *RG, *AQ, *KB, *VB; const float *qg, *kg;
    __device__ __forceinline__ void operator()(const f32x4 (&acc)[2][2][4][2], const Unit& u, int wr, int wc, int fr_, int fq_) const {
        int fr = fr_, fq = fq_; asm volatile("" : "+v"(fr), "+v"(fq));
        const int pn = u.pn; const bool ctx = u.pm >= 128;
        if (ctx && (pn < 2 || (pn >= 6 && pn < 10))) return;
        const int rowt = u.pm * BM + wr * 64 + fr;
        if (pn < 4) {
            const int head = 2 * (pn & 1) + (wc >> 1), dbase = 32 * (wc & 1) + 8 * fq; const bool isk = pn >= 2;
            bf16_t* dst = isk ? RK : RQ; const float sc = isk ? 0.08838834764831845f : 1.0f;
            float fqv[8];
#pragma unroll
            for (int i = 0; i < 8; ++i) fqv[i] = __builtin_amdgcn_exp2f(-(float)(dbase + i) * 0.20762050593046014f);
#pragma unroll
            for (int ai = 0; ai < 2; ++ai)
#pragma unroll
                for (int m = 0; m < 4; ++m) { const int row = rowt + ai * HALF + m * 16; const float t = (float)(row & 4095);
                    f32x4 o1[2], o2[2];
#pragma unroll
                    for (int n = 0; n < 2; ++n)
#pragma unroll
                        for (int j = 0; j < 4; ++j) { const float x1 = acc[ai][0][m][n][j], x2 = acc[ai][1][m][n][j]; float s = 0.f, c = 1.f;
                            if (!ctx) sincos_rad(t * fqv[4 * n + j], s, c);
                            o1[n][j] = (x1 * c - x2 * s) * sc; o2[n][j] = (x1 * s + x2 * c) * sc; }
                    bf16_t* p = dst + (size_t)row * 512 + head * 128 + dbase;
                    *(u32x4*)p = pack8(o1[0], o1[1]); *(u32x4*)(p + 64) = pack8(o2[0], o2[1]);  asm volatile("" ::: "memory"); }
        } else if (pn < 8) {
            const bool isg = pn >= 6; bf16_t* dst = isg ? RG : RV; const int col0 = (pn & 1) * 256 + wc * 32 + 8 * fq;
#pragma unroll
            for (int ai = 0; ai < 2; ++ai)
#pragma unroll
                for (int m = 0; m < 4; ++m) { const int row = rowt + ai * HALF + m * 16;
#pragma unroll
                    for (int bj = 0; bj < 2; ++bj) { f32x4 a = acc[ai][bj][m][0], b = acc[ai][bj][m][1];
                        if (isg) {
#pragma unroll
                            for (int j = 0; j < 4; ++j) { a[j] = a[j] * __builtin_amdgcn_rcpf(1.0f + __builtin_amdgcn_exp2f(-a[j] * 1.4426950408889634f)); b[j] = b[j] * __builtin_amdgcn_rcpf(1.0f + __builtin_amdgcn_exp2f(-b[j] * 1.4426950408889634f)); } }
                        *(u32x4*)(dst + (size_t)row * 512 + col0 + bj * HALF) = pack8(a, b); } }
        } else {
            const bool isq = pn < 10, isv = !isq && wc >= 2; const int d0 = 8 * fq;
            if (isv) {
#pragma unroll
                for (int ai = 0; ai < 2; ++ai)
#pragma unroll
                    for (int m = 0; m < 4; ++m) { const int row = rowt + ai * HALF + m * 16;
                        const int bb = ctx ? ((row - 32768) >> 8) : (row >> 12), ps = ctx ? ((row - 32768) & 255) : (256 + (row & 4095));
                        bf16_t* p = VB + ((size_t)((bb * 2 + (wc - 2)) * 68 + (ps >> 6))) * 4096 + ((ps & 63) >> 4) * 512 + ((ps & 15) * 4 + fq) * 8;
                        *(u32x4*)p = pack8(acc[ai][0][m][0], acc[ai][0][m][1]); *(u32x4*)(p + 4 * 512) = pack8(acc[ai][1][m][0], acc[ai][1][m][1]); }
            } else {
                const float* g = isq ? qg : kg; const float osc = isq ? 0.18033688011112042f : 1.0f;
                const f32x4 g1a = *(const f32x4*)(g + d0), g1b = *(const f32x4*)(g + d0 + 4), g2a = *(const f32x4*)(g + 32 + d0), g2b = *(const f32x4*)(g + 32 + d0 + 4);
                float afv[8];
#pragma unroll
                for (int i = 0; i < 8; ++i) afv[i] = __builtin_amdgcn_exp2f(-(float)(8 * (fq & 1) + i) * 0.8304820237218405f);
#pragma unroll
                for (int ai = 0; ai < 2; ++ai)
#pragma unroll
                    for (int m = 0; m < 4; ++m) { const int row = rowt + ai * HALF + m * 16; const int t = row & 4095;
                        const float pv = (float)((fq < 2) ? (t >> 6) : (t & 63));
                        float ss = 0.f;
#pragma unroll
                        for (int bj = 0; bj < 2; ++bj)
#pragma unroll
                            for (int n = 0; n < 2; ++n) { const f32x4 x = acc[ai][bj][m][n]; ss += (x[0] * x[0] + x[1] * x[1]) + (x[2] * x[2] + x[3] * x[3]); }
                        ss += __shfl_xor(ss, 16); ss += __shfl_xor(ss, 32);
                        const float rstd = __builtin_amdgcn_rsqf(ss * (1.0f / 64.0f) + 1e-6f);
                        f32x4 o1[2], o2[2];
#pragma unroll
                        for (int n = 0; n < 2; ++n)
#pragma unroll
                            for (int j = 0; j < 4; ++j) { const float y1 = acc[ai][0][m][n][j] * rstd * (n ? g1b[j] : g1a[j]), y2 = acc[ai][1][m][n][j] * rstd * (n ? g2b[j] : g2a[j]); float s = 0.f, c = 1.f;
                                if (!ctx) sincos_rad(pv * afv[4 * n + j], s, c);
                                o1[n][j] = (y1 * c - y2 * s) * osc; o2[n][j] = (y1 * s + y2 * c) * osc; }
                        bf16_t* p;
                        if (isq) p = AQ + (size_t)row * 512 + (4 * (pn - 8) + wc) * 64 + d0;
                        int h2 = 32;
                        if (!isq) { const int bb = ctx ? ((row - 32768) >> 8) : (row >> 12), ps = ctx ? ((row - 32768) & 255) : (256 + t);
                            p = KB + ((size_t)((bb * 2 + wc) * 68 + (ps >> 6))) * 4096 + fq * 512 + (ps & 63) * 8; h2 = 4 * 512; }
                        *(u32x4*)p = pack8(o1[0], o1[1]); *(u32x4*)(p + h2) = pack8(o2[0], o2[1]);  asm volatile("" ::: "memory"); }
            }
        }
    }
};

__device__ __forceinline__ float bflo(unsigned u) { return __builtin_bit_cast(float, u << 16); }
__device__ __forceinline__ float bfhi(unsigned u) { return __builtin_bit_cast(float, u & 0xffff0000u); }
struct EpiOut {
    static constexpr bool PERM = true, AFTER_DRAIN = false;
    const float* x; bf16_t* X1B; bf16_t* A2; const float* mod; const float* n2g; float* rowss;
    __device__ __forceinline__ void operator()(const f32x4 (&acc)[2][2][4][2], const Unit& u, int wr, int wc, int fr, int fq) const {
        const int b = u.pm >> 4; const float* mb = mod + (size_t)b * 6144; const int colb = u.pn * BM + wc * 32 + 8 * fq;
        f32x4 g1v[2][2], csv[2][2];
#pragma unroll
        for (int bj = 0; bj < 2; ++bj)
#pragma unroll
            for (int n = 0; n < 2; ++n) { const int c = colb + bj * HALF + 4 * n; g1v[bj][n] = *(const f32x4*)(mb + 2048 + c);
                const f32x4 s2 = *(const f32x4*)(mb + 4096 + c), gn = *(const f32x4*)(n2g + c); csv[bj][n] = gn * (s2 + 1.0f); }
#pragma unroll
        for (int aim = 0; aim < 4; ++aim) { const int ai = aim >> 1, m0 = (aim & 1) * 2;
            f32x4 xv[2][2][2];
#pragma unroll
            for (int mm = 0; mm < 2; ++mm)
#pragma unroll
                for (int bj = 0; bj < 2; ++bj) { const size_t off = (size_t)(u.pm * BM + ai * HALF + wr * 64 + (m0 + mm) * 16 + fr) * 1024 + colb + bj * HALF; xv[mm][bj][0] = *(const f32x4*)(x + off); xv[mm][bj][1] = *(const f32x4*)(x + off + 4); }
#pragma unroll
            for (int mm = 0; mm < 2; ++mm) asm volatile("" : "+v"(xv[mm][0][0]), "+v"(xv[mm][0][1]), "+v"(xv[mm][1][0]), "+v"(xv[mm][1][1]));
#pragma unroll
            for (int mm = 0; mm < 2; ++mm) { const int m = m0 + mm; const int row = u.pm * BM + ai * HALF + wr * 64 + m * 16 + fr; float ss = 0.f;
#pragma unroll
                for (int bj = 0; bj < 2; ++bj) { const size_t off = (size_t)row * 1024 + colb + bj * HALF;
                    const u32x4 xw = pack8(xv[mm][bj][0] + g1v[bj][0] * acc[ai][bj][m][0], xv[mm][bj][1] + g1v[bj][1] * acc[ai][bj][m][1]);
                    *(u32x4*)(X1B + off) = xw;
                    const f32x4 ya = (f32x4){bflo(xw.x), bfhi(xw.x), bflo(xw.y), bfhi(xw.y)}, yb = (f32x4){bflo(xw.z), bfhi(xw.z), bflo(xw.w), bfhi(xw.w)};
                    ss += (ya[0] * ya[0] + ya[1] * ya[1]) + (ya[2] * ya[2] + ya[3] * ya[3]) + (yb[0] * yb[0] + yb[1] * yb[1]) + (yb[2] * yb[2] + yb[3] * yb[3]);
                    *(u32x4*)(A2 + off) = pack8(ya * csv[bj][0], yb * csv[bj][1]); }
                ss += __shfl_xor(ss, 16); ss += __shfl_xor(ss, 32);
                if (fq == 0) atomicAdd(rowss + row, ss); }
        }
    }
};

struct EpiFF1 {
    static constexpr bool PERM = true, AFTER_DRAIN = false;
    bf16_t* HB; const float* bias2; const float* rowss;
    __device__ __forceinline__ void operator()(const f32x4 (&acc)[2][2][4][2], const Unit& u, int wr, int wc, int fr, int fq) const {
        const int b = u.pm >> 4; const int colb = u.pn * BM + wc * 32 + 8 * fq;
        f32x4 bv[2][2];
#pragma unroll
        for (int bj = 0; bj < 2; ++bj)
#pragma unroll
            for (int n = 0; n < 2; ++n) bv[bj][n] = *(const f32x4*)(bias2 + (size_t)b * 4096 + colb + bj * HALF + 4 * n);
        float rsv[2][4];
#pragma unroll
        for (int ai = 0; ai < 2; ++ai)
#pragma unroll
            for (int m = 0; m < 4; ++m) rsv[ai][m] = rowss[u.pm * BM + ai * HALF + wr * 64 + m * 16 + fr];
#pragma unroll
        for (int ai = 0; ai < 2; ++ai)
#pragma unroll
            for (int m = 0; m < 4; ++m) { const int row = u.pm * BM + ai * HALF + wr * 64 + m * 16 + fr;
                const float rstd = __builtin_amdgcn_rsqf(rsv[ai][m] * (1.0f / 1024.0f) + 1e-6f);
#pragma unroll
                for (int bj = 0; bj < 2; ++bj) { f32x4 a = acc[ai][bj][m][0] * rstd + bv[bj][0], c = acc[ai][bj][m][1] * rstd + bv[bj][1];
#pragma unroll
                    for (int j = 0; j < 4; ++j) { const float ra = __builtin_fmaxf(a[j], 0.f), rc = __builtin_fmaxf(c[j], 0.f); a[j] = ra * ra; c[j] = rc * rc; }
                    *(u32x4*)(HB + (size_t)row * 4096 + colb + bj * HALF) = pack8(a, c); } }
    }
};

struct EpiFF2N {
    static constexpr bool PERM = true, AFTER_DRAIN = false;
    const bf16_t* X1B; float* out; const float* mod; const float* fng; float* rowss2; unsigned* cnt;
    __device__ __forceinline__ void operator()(f32x4 (&acc)[2][2][4][2], const Unit& u, int wr, int wc, int fr, int fq) const {
        const int b = u.pm >> 4; const float* mb = mod + (size_t)b * 6144 + 5120; const int colb = u.pn * BM + wc * 32 + 8 * fq;
        {
            f32x4 gv[2][2];
#pragma unroll
            for (int bj = 0; bj < 2; ++bj)
#pragma unroll
                for (int n = 0; n < 2; ++n) gv[bj][n] = *(const f32x4*)(mb + colb + bj * HALF + 4 * n);
#pragma unroll
            for (int ai = 0; ai < 2; ++ai) {
                u32x4 xw[4][2];
#pragma unroll
                for (int m = 0; m < 4; ++m)
#pragma unroll
                    for (int bj = 0; bj < 2; ++bj) xw[m][bj] = *(const u32x4*)(X1B + (size_t)(u.pm * BM + ai * HALF + wr * 64 + m * 16 + fr) * 1024 + colb + bj * HALF);
#pragma unroll
                for (int m = 0; m < 4; ++m) asm volatile("" : "+v"(xw[m][0]), "+v"(xw[m][1]));
#pragma unroll
                for (int m = 0; m < 4; ++m) { const int row = u.pm * BM + ai * HALF + wr * 64 + m * 16 + fr; float ss = 0.f;
#pragma unroll
                    for (int bj = 0; bj < 2; ++bj) { const u32x4 dw = xw[m][bj];
                        const f32x4 ya = (f32x4){bflo(dw.x), bfhi(dw.x), bflo(dw.y), bfhi(dw.y)} + gv[bj][0] * acc[ai][bj][m][0], yb = (f32x4){bflo(dw.z), bfhi(dw.z), bflo(dw.w), bfhi(dw.w)} + gv[bj][1] * acc[ai][bj][m][1];
                        acc[ai][bj][m][0] = ya; acc[ai][bj][m][1] = yb;
                        ss += (ya[0] * ya[0] + ya[1] * ya[1]) + (ya[2] * ya[2] + ya[3] * ya[3]) + (yb[0] * yb[0] + yb[1] * yb[1]) + (yb[2] * yb[2] + yb[3] * yb[3]); }
                    ss += __shfl_xor(ss, 16); ss += __shfl_xor(ss, 32);
                    if (fq == 0) __hip_atomic_fetch_add(rowss2 + row, ss, __ATOMIC_RELAXED, __HIP_MEMORY_SCOPE_AGENT); }
            }
        }
        asm volatile("s_waitcnt vmcnt(0)" ::: "memory");
        unsigned* cw = cnt + 64 * u.pm;
        if ((fr | fq) == 0) __hip_atomic_fetch_add(cw, 1u, __ATOMIC_RELAXED, __HIP_MEMORY_SCOPE_AGENT);
        { unsigned spins = 0;
          while ((unsigned)__builtin_amdgcn_readfirstlane(__hip_atomic_load(cw, __ATOMIC_RELAXED, __HIP_MEMORY_SCOPE_AGENT)) < 32u) { __builtin_amdgcn_s_sleep(4); if (++spins > (1u << 22)) break; } }
        asm volatile("" ::: "memory");
        f32x4 fg[2][2];
#pragma unroll
        for (int bj = 0; bj < 2; ++bj)
#pragma unroll
            for (int n = 0; n < 2; ++n) fg[bj][n] = *(const f32x4*)(fng + colb + bj * HALF + 4 * n);
        float totv[2][4];
#pragma unroll
        for (int ai = 0; ai < 2; ++ai)
#pragma unroll
            for (int m = 0; m < 4; ++m) totv[ai][m] = __hip_atomic_load(rowss2 + u.pm * BM + ai * HALF + wr * 64 + m * 16 + fr, __ATOMIC_RELAXED, __HIP_MEMORY_SCOPE_AGENT);
#pragma unroll
        for (int ai = 0; ai < 2; ++ai)
#pragma unroll
            for (int m = 0; m < 4; ++m) { const int row = u.pm * BM + ai * HALF + wr * 64 + m * 16 + fr;
                const float tot = totv[ai][m];
                const float rstd = 1.0f / __builtin_sqrtf(tot * (1.0f / 1024.0f) + 1e-6f);
#pragma unroll
                for (int bj = 0; bj < 2; ++bj) { const size_t off = (size_t)row * 1024 + colb + bj * HALF;
                    *(f32x4*)(out + off) = (acc[ai][bj][m][0] * rstd) * fg[bj][0]; *(f32x4*)(out + off + 4) = (acc[ai][bj][m][1] * rstd) * fg[bj][1]; }
                if (m & 1) asm volatile("" ::: "memory"); }
    }
};

template <class Epi, class Sched, bool ALIGN_EPI = false, bool SP2 = false>
__device__ __forceinline__ void gemm_phase(PG8_LAS unsigned char* lds, const Gemm g, const Sched& S, const Epi& E) {
    int tid_ = threadIdx.x; asm volatile("" : "+v"(tid_));
    const int tid = tid_, wid = __builtin_amdgcn_readfirstlane(tid >> 6), lane = tid & 63, wr = wid >> 2, wc = wid & 3, fr = lane & 15, fq = lane >> 4;
    const int K = g.K, nt = K / BK;
    unsigned voffA[2], voffB[2];
#pragma unroll
    for (int i = 0; i < 2; ++i) { int R, C; stage_rc(tid * 16 + i * 8192, R, C); const int Rb = Epi::PERM ? ((R & ~31) + perm32(R & 31)) : R;
        voffA[i] = (unsigned)(R * K + C) * 2u; voffB[i] = (unsigned)(Rb * K + C) * 2u; }
    const size_t kstep = (size_t)(BK * 2);
    const size_t hstep = (size_t)HALF * K * 2;
    const size_t tstep = 2 * hstep;
    const unsigned ldsw = (unsigned)wid * 1024u;
    const int aoff = lds_byte(wr * 64 + fr, fq * 8), boff = lds_byte(wc * 32 + fr, fq * 8);
#define PG8_SA(b, h) (((b) * 2 + (h)) * HTB)
#define PG8_SB(b, h) ((4 + (b) * 2 + (h)) * HTB)
#define PG8_STAGE(bufoff, gbase, voff) do { _Pragma("unroll") for (int _i = 0; _i < 2; ++_i) \
        __builtin_amdgcn_global_load_lds((const unsigned*)((const char*)(gbase) + (voff)[_i]), (PG8_LAS unsigned*)(lds + (bufoff) + ldsw + _i * 8192), 16, 0, 0); } while (0)
#define PG8_LDA(dst, b, h) do { _Pragma("unroll") for (int m = 0; m < 4; ++m) _Pragma("unroll") for (int k = 0; k < 2; ++k) dst[m][k] = *(const PG8_LAS bf16x8*)(lds + PG8_SA(b, h) + aoff + m * 2048 + k * 1024); } while (0)
#define PG8_LDB(dst, b, h) do { _Pragma("unroll") for (int n = 0; n < 2; ++n) _Pragma("unroll") for (int k = 0; k < 2; ++k) dst[n][k] = *(const PG8_LAS bf16x8*)(lds + PG8_SB(b, h) + boff + n * 2048 + k * 1024); } while (0)
#define PG8_MMA(ai, bj, At, Bt) do { __builtin_amdgcn_s_setprio(1); _Pragma("unroll") for (int m = 0; m < 4; ++m) _Pragma("unroll") for (int n = 0; n < 2; ++n) _Pragma("unroll") for (int k = 0; k < 2; ++k) \
        acc[ai][bj][m][n] = __builtin_amdgcn_mfma_f32_16x16x32_bf16(Bt[n][k], At[m][k], acc[ai][bj][m][n], 0, 0, 0); __builtin_amdgcn_s_setprio(0); } while (0)
#define PG8_WAIT_V(n) asm volatile("s_waitcnt vmcnt(" #n ")" ::: "memory")
#define PG8_WAIT_L(n) asm volatile("s_waitcnt lgkmcnt(" #n ")" ::: "memory")
#define PG8_BAR __builtin_amdgcn_s_barrier()
#define PG8_SCHED __builtin_amdgcn_sched_barrier(0)
    Unit cur, nxt; int ui = 0;
    if (!S.next(0, cur)) return;
    f32x4 acc[2][2][4][2];
#pragma unroll
    for (int a = 0; a < 2; ++a)
#pragma unroll
        for (int b = 0; b < 2; ++b)
#pragma unroll
            for (int m = 0; m < 4; ++m)
#pragma unroll
                for (int n = 0; n < 2; ++n) acc[a][b][m][n] = (f32x4){0.f, 0.f, 0.f, 0.f};
    bf16x8 At[4][2], B0[2][2], B1[2][2];
    const char* cA = (const char*)g.A + (size_t)cur.pm * tstep; const char* cB = (const char*)g.Bt + (size_t)cur.pn * tstep;
    S.a_ready(cur);
    if constexpr (SP2) {
        PG8_STAGE(PG8_SB(0, 0), cB, voffB); PG8_STAGE(PG8_SB(0, 1), cB + hstep, voffB); PG8_STAGE(PG8_SA(0, 0), cA, voffA); PG8_STAGE(PG8_SA(0, 1), cA + hstep, voffA);
        if (wr == 1) PG8_BAR;
        PG8_WAIT_V(2); PG8_BAR;
        PG8_STAGE(PG8_SB(1, 0), cB + kstep, voffB); PG8_STAGE(PG8_SA(1, 0), cA + kstep, voffA); PG8_STAGE(PG8_SB(1, 1), cB + hstep + kstep, voffB);
        PG8_WAIT_V(6); PG8_BAR;
    } else {
        PG8_STAGE(PG8_SB(0, 0), cB, voffB); PG8_STAGE(PG8_SA(0, 0), cA, voffA); PG8_STAGE(PG8_SB(0, 1), cB + hstep, voffB); PG8_STAGE(PG8_SA(0, 1), cA + hstep, voffA);
        if (wr == 1) PG8_BAR;
        PG8_WAIT_V(4); PG8_BAR;
        PG8_STAGE(PG8_SB(1, 0), cB + kstep, voffB); PG8_STAGE(PG8_SA(1, 0), cA + kstep, voffA); PG8_STAGE(PG8_SB(1, 1), cB + hstep + kstep, voffB);
        PG8_WAIT_V(6); PG8_BAR;
    }
    for (;;) {
        const bool has_next = S.next(ui + 1, nxt);
        const char* nA = has_next ? (const char*)g.A + (size_t)nxt.pm * tstep : cA; const char* nB = has_next ? (const char*)g.Bt + (size_t)nxt.pn * tstep : cB;
        for (int t = 0; t < nt; t += 2) {
            const bool last = (t == nt - 2);
            const char* a1 = cA + (size_t)(t + 1) * kstep;
            const char* a2 = last ? nA : cA + (size_t)(t + 2) * kstep; const char* b2 = last ? nB : cB + (size_t)(t + 2) * kstep;
            const char* a3 = a2 + kstep; const char* b3 = b2 + kstep;
            if (last && has_next) S.a_ready(nxt);
            if constexpr (SP2) {
            PG8_LDB(B0, 0, 0); PG8_LDB(B1, 0, 1); PG8_SCHED; PG8_LDA(At, 0, 0); PG8_STAGE(PG8_SA(1, 1), a1 + hstep, voffA);
            PG8_WAIT_V(8); PG8_WAIT_L(0); PG8_BAR; PG8_MMA(0, 0, At, B0); PG8_MMA(0, 1, At, B1); PG8_BAR; PG8_SCHED;
            PG8_LDA(At, 0, 1); PG8_STAGE(PG8_SB(0, 0), b2, voffB); PG8_STAGE(PG8_SB(0, 1), b2 + hstep, voffB); PG8_STAGE(PG8_SA(0, 0), a2, voffA);
            PG8_WAIT_V(8); PG8_WAIT_L(0); PG8_BAR; PG8_MMA(1, 0, At, B0); PG8_MMA(1, 1, At, B1); PG8_BAR; PG8_SCHED;
            PG8_LDB(B0, 1, 0); PG8_LDB(B1, 1, 1); PG8_SCHED; PG8_LDA(At, 1, 0); PG8_STAGE(PG8_SA(0, 1), a2 + hstep, voffA);
            PG8_WAIT_V(8); PG8_WAIT_L(0); PG8_BAR; PG8_MMA(0, 0, At, B0); PG8_MMA(0, 1, At, B1); PG8_BAR; PG8_SCHED;
            PG8_LDA(At, 1, 1); PG8_STAGE(PG8_SB(1, 0), b3, voffB); PG8_STAGE(PG8_SB(1, 1), b3 + hstep, voffB); PG8_STAGE(PG8_SA(1, 0), a3, voffA);
            PG8_WAIT_V(8); PG8_WAIT_L(0); PG8_BAR; PG8_MMA(1, 0, At, B0); PG8_MMA(1, 1, At, B1); PG8_BAR; PG8_SCHED;
            } else {
            PG8_LDB(B0, 0, 0); PG8_SCHED; PG8_LDA(At, 0, 0); PG8_STAGE(PG8_SA(1, 1), a1 + hstep, voffA);
            PG8_WAIT_L(8); PG8_BAR; PG8_WAIT_L(0); PG8_MMA(0, 0, At, B0); PG8_BAR; PG8_SCHED;
            PG8_LDB(B1, 0, 1); PG8_STAGE(PG8_SB(0, 0), b2, voffB);
            PG8_BAR; PG8_WAIT_L(0); PG8_MMA(0, 1, At, B1); PG8_BAR;
            PG8_LDA(At, 0, 1); PG8_STAGE(PG8_SA(0, 0), a2, voffA);
            PG8_BAR; PG8_WAIT_L(0); PG8_MMA(1, 0, At, B0); PG8_BAR; PG8_SCHED;
            PG8_STAGE(PG8_SB(0, 1), b2 + hstep, voffB);
            PG8_WAIT_V(6); PG8_BAR; PG8_MMA(1, 1, At, B1); PG8_BAR;
            PG8_LDB(B0, 1, 0); PG8_SCHED; PG8_LDA(At, 1, 0); PG8_STAGE(PG8_SA(0, 1), a2 + hstep, voffA);
            PG8_WAIT_L(8); PG8_BAR; PG8_WAIT_L(0); PG8_MMA(0, 0, At, B0); PG8_BAR; PG8_SCHED;
            PG8_LDB(B1, 1, 1); PG8_STAGE(PG8_SB(1, 0), b3, voffB);
            PG8_BAR; PG8_WAIT_L(0); PG8_MMA(0, 1, At, B1); PG8_BAR;
            PG8_LDA(At, 1, 1); PG8_STAGE(PG8_SA(1, 0), a3, voffA);
            PG8_BAR; PG8_WAIT_L(0); PG8_MMA(1, 0, At, B0); PG8_BAR; PG8_SCHED;
            PG8_STAGE(PG8_SB(1, 1), b3 + hstep, voffB);
            PG8_WAIT_V(6); PG8_BAR; PG8_MMA(1, 1, At, B1); PG8_BAR;
            }
        }
        if constexpr (ALIGN_EPI) { if (wr == 0) PG8_BAR; }
        if constexpr (!Epi::AFTER_DRAIN) { E(acc, cur, wr, wc, fr, fq); S.done(cur); }
        if (!has_next) break;
#pragma unroll
        for (int a = 0; a < 2; ++a)
#pragma unroll
            for (int b = 0; b < 2; ++b)
#pragma unroll
                for (int m = 0; m < 4; ++m)
#pragma unroll
                    for (int n = 0; n < 2; ++n) acc[a][b][m][n] = (f32x4){0.f, 0.f, 0.f, 0.f};
        cur = nxt; cA = nA; cB = nB; ++ui;
        if constexpr (ALIGN_EPI) { if (wr == 1) PG8_BAR; }
    }
    PG8_WAIT_V(0);
    if constexpr (!ALIGN_EPI) { if (wr == 0) PG8_BAR; }
    PG8_BAR;
    if constexpr (Epi::AFTER_DRAIN) { E.fused(acc, cur, wr, wc, fr, fq, lds, wid, lane); S.done(cur); }
#undef PG8_SA
#undef PG8_SB
#undef PG8_STAGE
#undef PG8_LDA
#undef PG8_LDB
#undef PG8_MMA
#undef PG8_WAIT_V
#undef PG8_WAIT_L
#undef PG8_BAR
#undef PG8_SCHED
}
}

#ifndef PG8_SP2
#define PG8_SP2 true
#endif
#ifndef PG8_ALIGN
#define PG8_ALIGN true
#endif
#include <hip/hip_bf16.h>
#include <cmath>
namespace attn_body {
using bf16=__hip_bfloat16;
using bf16x8=__attribute__((ext_vector_type(8)))short;
using s16x4=__attribute__((ext_vector_type(4)))short;
using f32x16=__attribute__((ext_vector_type(16)))float;
using u32x4=__attribute__((ext_vector_type(4)))unsigned;
constexpr int BATCH=8,NHEAD=8,SEQ=4096,KVLEN=4352,D=64,QP=512,KP=128,OP=1024,OCOL0=512;
constexpr int NW=8,QBLK=32,QB=QBLK*NW,KVBLK=64,NQB=SEQ/QB;
constexpr int ATTN_UNIT_ROWS=QB;
__device__ __forceinline__ int crow(int r,int hi){return (r&3)+8*(r>>2)+4*hi;}
#define SBAR() __builtin_amdgcn_sched_barrier(0)
__device__ __forceinline__ void cmask(f32x16&p0,f32x16&p1,int jb,int qrel,int hi){
  const float NEG=-INFINITY; int kb=64*jb+4*hi;
  #pragma unroll
  for(int r=0;r<16;++r){int kv=kb+(r&3)+8*(r>>2); if(kv>qrel)p0[r]=NEG; if(kv+32>qrel)p1[r]=NEG;}
}

constexpr int NSLOT=3, SLOTB=8192;
constexpr int LDS_K=0, LDS_V=NSLOT*SLOTB, LDS_WS=2*NSLOT*SLOTB, LDS_OST=LDS_WS+NW*64*4, LDS_BYTES=LDS_OST+NW*4096;
constexpr float C2=0.125f*1.4426950408889634f;
__device__ __forceinline__ void glds16(const void*gsrc,unsigned lds_dst){unsigned keep;
  asm volatile("s_mov_b32 %0, m0\n\ts_mov_b32 m0, %2\n\ts_nop 0\n\tglobal_load_lds_dwordx4 %1, off\n\ts_mov_b32 m0, %0":"=&s"(keep):"v"(gsrc),"s"(lds_dst):"memory");}
__device__ __forceinline__ float max3f(float a,float b,float c){float r;asm("v_max3_f32 %0, %1, %2, %3":"=v"(r):"v"(a),"v"(b),"v"(c));return r;}
__device__ __forceinline__ float max2f(float a,float b){float r;asm("v_max_f32_e32 %0, %1, %2":"=v"(r):"v"(a),"v"(b));return r;}
__device__ __forceinline__ float fadd_s(float a,float b){float r;asm("v_add_f32_e32 %0, %1, %2":"=v"(r):"v"(a),"v"(b));return r;}
__device__ __forceinline__ float fsub_s(float a,float b){float r;asm("v_sub_f32_e32 %0, %1, %2":"=v"(r):"v"(a),"v"(b));return r;}
typedef float f32x2_t __attribute__((ext_vector_type(2))); typedef __bf16 bf16x2_t __attribute__((ext_vector_type(2)));
__device__ __forceinline__ unsigned cvtpk_s(float lo,float hi){f32x2_t v={lo,hi};bf16x2_t b=__builtin_convertvector(v,bf16x2_t);return __builtin_bit_cast(unsigned,b);}
#define WAIT_BAR(N) asm volatile("s_waitcnt vmcnt(" #N ") lgkmcnt(0)\n\ts_barrier":::"memory")

__device__ __forceinline__ void qkt(f32x16&p0,f32x16&p1,const char*Kslot,const bf16x8*qr,const f32x16&negm,int r32,int hi){
  const char*kb=Kslot+hi*1024+r32*16;
  #pragma unroll
  for(int d0=0;d0<4;++d0){
    const bf16x8 b0=*reinterpret_cast<const bf16x8*>(kb+d0*2048);
    const bf16x8 b1=*reinterpret_cast<const bf16x8*>(kb+d0*2048+512);
    if(d0==0){p0=__builtin_amdgcn_mfma_f32_32x32x16_bf16(b0,qr[0],negm,0,0,0);p1=__builtin_amdgcn_mfma_f32_32x32x16_bf16(b1,qr[0],negm,0,0,0);}
    else{p0=__builtin_amdgcn_mfma_f32_32x32x16_bf16(b0,qr[d0],p0,0,0,0);p1=__builtin_amdgcn_mfma_f32_32x32x16_bf16(b1,qr[d0],p1,0,0,0);}}
}
typedef __attribute__((address_space(3))) const char* lds_cptr;
typedef short v4i16_t __attribute__((ext_vector_type(4)));
__device__ __forceinline__ void kload8(bf16x8*kf,lds_cptr kp){
  kf[0]=*(const __attribute__((address_space(3))) bf16x8*)(kp);      kf[1]=*(const __attribute__((address_space(3))) bf16x8*)(kp+512);
  kf[2]=*(const __attribute__((address_space(3))) bf16x8*)(kp+2048); kf[3]=*(const __attribute__((address_space(3))) bf16x8*)(kp+2560);
  kf[4]=*(const __attribute__((address_space(3))) bf16x8*)(kp+4096); kf[5]=*(const __attribute__((address_space(3))) bf16x8*)(kp+4608);
  kf[6]=*(const __attribute__((address_space(3))) bf16x8*)(kp+6144); kf[7]=*(const __attribute__((address_space(3))) bf16x8*)(kp+6656);
}
__device__ __forceinline__ void kload2(bf16x8*kf,lds_cptr kp,int j){ kf[2*j]=*(const __attribute__((address_space(3))) bf16x8*)(kp+j*2048); kf[2*j+1]=*(const __attribute__((address_space(3))) bf16x8*)(kp+j*2048+512); }
__device__ __forceinline__ s16x4 vtr(lds_cptr p){ return __builtin_bit_cast(s16x4,__builtin_amdgcn_ds_read_tr16_b64_v4i16((__attribute__((address_space(3))) v4i16_t*)p)); }
__device__ __forceinline__ float rowmax(const f32x16&p0,const f32x16&p1){
  float a=max3f(p0[0],p0[1],p1[0]),b=max3f(p0[2],p0[3],p1[1]);a=max3f(a,p1[2],p1[3]);
  #pragma unroll
  for(int r=4;r<16;r+=4){a=max3f(a,p0[r],p0[r+1]);b=max3f(b,p0[r+2],p0[r+3]);a=max3f(a,p1[r],p1[r+1]);b=max3f(b,p1[r+2],p1[r+3]);}
  const float m=max2f(a,b);
  auto rr=__builtin_amdgcn_permlane32_swap(__float_as_uint(m),__float_as_uint(m),false,false);
  return max2f(__uint_as_float(rr[0]),__uint_as_float(rr[1]));
}
__device__ __forceinline__ void pv(f32x16*o,int vb,bf16x8 pa0,bf16x8 pa1,bf16x8 pa2,bf16x8 pa3){
  #pragma unroll
  for(int d0=0;d0<2;++d0){s16x4 lo[4],hi[4];
    #pragma unroll
    for(int ks=0;ks<4;++ks){
      asm volatile("ds_read_b64_tr_b16 %0,%1 offset:%c2":"=&v"(lo[ks]):"v"(vb),"i"(d0*4096+ks*1024):"memory");
      asm volatile("ds_read_b64_tr_b16 %0,%1 offset:%c2":"=&v"(hi[ks]):"v"(vb),"i"(d0*4096+ks*1024+512):"memory");}
    asm volatile("s_waitcnt lgkmcnt(0)":::"memory");SBAR();
    #define PK(k) (bf16x8){lo[k][0],lo[k][1],lo[k][2],lo[k][3],hi[k][0],hi[k][1],hi[k][2],hi[k][3]}
    o[d0]=__builtin_amdgcn_mfma_f32_32x32x16_bf16(pa0,PK(0),o[d0],0,0,0);
    o[d0]=__builtin_amdgcn_mfma_f32_32x32x16_bf16(pa1,PK(1),o[d0],0,0,0);
    o[d0]=__builtin_amdgcn_mfma_f32_32x32x16_bf16(pa2,PK(2),o[d0],0,0,0);
    o[d0]=__builtin_amdgcn_mfma_f32_32x32x16_bf16(pa3,PK(3),o[d0],0,0,0);
    #undef PK
  }
}

#ifndef ATTN_STORE16
#define ATTN_STORE16(p,v) (*(u32x4*)(p)=(v))
#endif
template<int THRL> __device__ __forceinline__ void attn_unit(int b,int h,int qb,const bf16*Q,const bf16*__restrict__ K,const bf16*__restrict__ V,bf16*O,char*shm){
  int tid_=threadIdx.x; asm volatile("":"+v"(tid_));
  const int tid=tid_,lane=tid&63,r32=lane&31,hi=lane>>5; const int wid=__builtin_amdgcn_readfirstlane(tid>>6);
  const long rowbase=(long)b*SEQ; const long kvbase=(long)b*KVLEN; const int q0=qb*QB;
  const bf16*Qw=Q+(rowbase+q0+wid*QBLK)*QP+h*D;
  const bf16*Kh=K+((long)(b*2+(h>>2))*(KVLEN/KVBLK))*4096,*Vh=V+((long)(b*2+(h>>2))*(KVLEN/KVBLK))*4096;
  const unsigned lds0=(unsigned)(uintptr_t)shm;
  float*wsf=(float*)(shm+LDS_WS)+wid*64;
  const bf16*ksrc=Kh+wid*512+lane*8;
  const bf16*vsrc=Vh+wid*512+lane*8;
  const unsigned kdst=lds0+LDS_K+wid*1024, vdst=lds0+LDS_V+wid*1024;
  #define DMA_K(t,slot) glds16(ksrc+(long)(t)*4096,(unsigned)__builtin_amdgcn_readfirstlane(kdst+(slot)))
  #define DMA_V(t,slot) glds16(vsrc+(long)(t)*4096,(unsigned)__builtin_amdgcn_readfirstlane(vdst+(slot)))
  const int vb0=(int)(lds0+LDS_V)+((lane>>4)&1)*32+(lane&3)*8+(4*hi+((lane&15)>>2))*64;
  const char*Kbase=shm+LDS_K; bf16x8 kf[8];
  const lds_cptr shm3=(lds_cptr)shm; const lds_cptr kp0=shm3+LDS_K+hi*1024+r32*16; const lds_cptr vp0=shm3+LDS_V+((lane>>4)&1)*32+(lane&3)*8+(4*hi+((lane&15)>>2))*64;
  const int NT=KVLEN/KVBLK;
  DMA_K(0,0);DMA_V(0,0);DMA_K(1,SLOTB);
  bf16x8 qr[4];
  #pragma unroll
  for(int d0=0;d0<4;++d0)qr[d0]=*reinterpret_cast<const bf16x8*>(&Qw[(long)r32*QP+d0*16+hi*8]);
  float mhat=0.f,l_reg=0.f;f32x16 o[2];o[0]=f32x16{};o[1]=f32x16{};f32x16 negm=f32x16{};asm volatile("":"+v"(negm));
    #define CMASK(P0,P1,t) do{}while(0)
  bool resc=false;
  #define START(P0,P1) do{ const float rm=rowmax(P0,P1); resc=false; \
    { const float dl=rm; mhat=fadd_s(mhat,dl); \
      _Pragma("unroll") for(int r=0;r<16;++r){P0[r]=fsub_s(P0[r],dl);P1[r]=fsub_s(P1[r],dl);} \
      _Pragma("unroll") for(int r=0;r<16;++r)negm[r]=-mhat; asm volatile("":"+v"(negm)); } \
    _Pragma("unroll") for(int r=0;r<16;++r)P0[r]=__builtin_amdgcn_exp2f(P0[r]); }while(0)
  #define RESC() do{ if(resc){ asm volatile("s_waitcnt lgkmcnt(0)":::"memory"); \
      _Pragma("unroll") for(int d_=0;d_<2;++d_) _Pragma("unroll") for(int r=0;r<16;++r)o[d_][r]*=wsf[crow(r,hi)]; } }while(0)
  f32x16 pA0,pA1,pB0,pB1;
  int sl_prev=0,sl_cur=0,sl_next=SLOTB;
  #define ROT() do{sl_prev=sl_cur;sl_cur=sl_next;sl_next=(sl_next==(NSLOT-1)*SLOTB)?0:sl_next+SLOTB;}while(0)
  DMA_K(2,2*SLOTB);
  WAIT_BAR(3);
  qkt(pA0,pA1,Kbase,qr,negm,r32,hi);asm volatile("s_nop 15\n\ts_nop 7":"+v"(pA0),"+v"(pA1));CMASK(pA0,pA1,0);
  START(pA0,pA1);
  _Pragma("unroll") for(int r=0;r<16;++r)pA1[r]=__builtin_amdgcn_exp2f(pA1[r]);
  WAIT_BAR(0);
  DMA_K(3,0);DMA_V(1,SLOTB);
  ROT();
  kload8(kf,kp0+sl_cur);
  WAIT_BAR(2);
  s16x4 vlo[8],vhi[8]; u32x4 pw0,pw1,pw2,pw3;
  #define PKW(P,B) cvtpk_s(P[B],P[B+1])
  #define PAF(k) __builtin_bit_cast(bf16x8,pw##k)
  #define VFR(i) (bf16x8){vlo[i][0],vlo[i][1],vlo[i][2],vlo[i][3],vhi[i][0],vhi[i][1],vhi[i][2],vhi[i][3]}
  #define PIN(x) asm volatile("":"+v"(x))
  #define MX3(a,b,c) __builtin_fmaxf(__builtin_fmaxf((a),(b)),(c))
  #define GAPA(MF,A0,A1,A2,A3,W0,W1,PW) do{ MF; sacc+=A0; sacc+=A1; sacc+=A2; sacc+=A3; PIN(sacc); W0; W1; PIN(PW); SBAR(); }while(0)
  #define EX(v) __builtin_amdgcn_exp2f(v)
  #define GAPB(MF,X,B) do{ MF; X[B]=EX(X[B]); X[B+1]=EX(X[B+1]); X[B+2]=EX(X[B+2]); X[B+3]=EX(X[B+3]); PIN(X); SBAR(); }while(0)
  #define VRD(i) do{ vlo[i]=vtr(vp_+(((i)>>2)*4096+((i)&3)*1024)); vhi[i]=vtr(vp_+(((i)>>2)*4096+((i)&3)*1024+512)); }while(0)
  #define KRD(G,j) do{ if(G){ kload2(kf,kp0+sl_next,j); SBAR(); } }while(0)
  #define STEP(C0,C1,P0,P1,t,GK,GV,GL) do{ SBAR(); \
    const lds_cptr vp_=vp0+sl_prev; \
    VRD(0); SBAR(); float sacc=(P0[0]+P0[1]); \
    GAPA(C0=__builtin_amdgcn_mfma_f32_32x32x16_bf16(kf[0],qr[0],negm,0,0,0), P0[2],P0[3],P0[4],P0[5],     pw0[0]=PKW(P0,0), pw0[1]=PKW(P0,2), pw0); \
    VRD(4); SBAR(); GAPA(C1=__builtin_amdgcn_mfma_f32_32x32x16_bf16(kf[1],qr[0],negm,0,0,0), P0[6],P0[7],P0[8],P0[9],     pw0[2]=PKW(P0,4), pw0[3]=PKW(P0,6), pw0); \
    VRD(1); SBAR(); GAPA(C0=__builtin_amdgcn_mfma_f32_32x32x16_bf16(kf[2],qr[1],C0,0,0,0),   P0[10],P0[11],P0[12],P0[13], pw1[0]=PKW(P0,8), pw1[1]=PKW(P0,10), pw1); \
    VRD(5); SBAR(); GAPA(C1=__builtin_amdgcn_mfma_f32_32x32x16_bf16(kf[3],qr[1],C1,0,0,0),   P0[14],P0[15],P1[0],P1[1],   pw1[2]=PKW(P0,12),pw1[3]=PKW(P0,14), pw1); \
    VRD(2); SBAR(); GAPA(C0=__builtin_amdgcn_mfma_f32_32x32x16_bf16(kf[4],qr[2],C0,0,0,0),   P1[2],P1[3],P1[4],P1[5],     pw2[0]=PKW(P1,0), pw2[1]=PKW(P1,2), pw2); \
    VRD(6); SBAR(); GAPA(C1=__builtin_amdgcn_mfma_f32_32x32x16_bf16(kf[5],qr[2],C1,0,0,0),   P1[6],P1[7],P1[8],P1[9],     pw2[2]=PKW(P1,4), pw2[3]=PKW(P1,6), pw2); \
    VRD(3); SBAR(); GAPA(C0=__builtin_amdgcn_mfma_f32_32x32x16_bf16(kf[6],qr[3],C0,0,0,0),   P1[10],P1[11],P1[12],P1[13], pw3[0]=PKW(P1,8), pw3[1]=PKW(P1,10), pw3); \
    VRD(7); SBAR(); GAPA(C1=__builtin_amdgcn_mfma_f32_32x32x16_bf16(kf[7],qr[3],C1,0,0,0),   P1[14],P1[15],0.f,0.f,       pw3[2]=PKW(P1,12),pw3[3]=PKW(P1,14), pw3); \
    l_reg+=sacc; \
    if(GK){DMA_K((t)+3,sl_cur);} if(GV){DMA_V((t)+1,sl_next);} \
    CMASK(C0,C1,t); \
    { float a=MX3(C0[0],C0[1],C1[0]),b=MX3(C0[2],C0[3],C1[1]); a=MX3(a,C1[2],C1[3]); \
      _Pragma("unroll") for(int r=4;r<16;r+=4){a=MX3(a,C0[r],C0[r+1]);b=MX3(b,C0[r+2],C0[r+3]);a=MX3(a,C1[r],C1[r+1]);b=MX3(b,C1[r+2],C1[r+3]);} \
      float rm=__builtin_fmaxf(a,b); { auto rr=__builtin_amdgcn_permlane32_swap(__float_as_uint(rm),__float_as_uint(rm),false,false); rm=__builtin_fmaxf(__uint_as_float(rr[0]),__uint_as_float(rr[1])); } \
      resc=false; \
      if(__builtin_expect(__any(rm>(float)THRL),0)){ const float dl=__builtin_fmaxf(rm,0.f); mhat+=dl; \
        _Pragma("unroll") for(int r=0;r<16;++r){C0[r]-=dl;C1[r]-=dl;} \
        _Pragma("unroll") for(int r=0;r<16;++r)negm[r]=-mhat; asm volatile("":"+v"(negm)); \
        const float f=__builtin_amdgcn_exp2f(-dl); l_reg*=f; if(hi==0)wsf[r32]=f; resc=true; } } \
    SBAR(); \
    GAPB(o[0]=__builtin_amdgcn_mfma_f32_32x32x16_bf16(PAF(0),VFR(0),o[0],0,0,0), C0,0); \
    GAPB(o[1]=__builtin_amdgcn_mfma_f32_32x32x16_bf16(PAF(0),VFR(4),o[1],0,0,0), C0,4); \
    KRD(GL,0); GAPB(o[0]=__builtin_amdgcn_mfma_f32_32x32x16_bf16(PAF(1),VFR(1),o[0],0,0,0), C0,8); \
    KRD(GL,1); GAPB(o[1]=__builtin_amdgcn_mfma_f32_32x32x16_bf16(PAF(1),VFR(5),o[1],0,0,0), C0,12); \
    KRD(GL,2); GAPB(o[0]=__builtin_amdgcn_mfma_f32_32x32x16_bf16(PAF(2),VFR(2),o[0],0,0,0), C1,0); \
    KRD(GL,3); GAPB(o[1]=__builtin_amdgcn_mfma_f32_32x32x16_bf16(PAF(2),VFR(6),o[1],0,0,0), C1,4); \
    GAPB(o[0]=__builtin_amdgcn_mfma_f32_32x32x16_bf16(PAF(3),VFR(3),o[0],0,0,0), C1,8); \
    GAPB(o[1]=__builtin_amdgcn_mfma_f32_32x32x16_bf16(PAF(3),VFR(7),o[1],0,0,0), C1,12); \
    }while(0)
  int t=1;
  #undef CMASK
  #define CMASK(P0,P1,t) do{}while(0)
  for(;t+5<NT;t+=2){
    STEP(pB0,pB1,pA0,pA1,t,true,true,true);     WAIT_BAR(2); RESC(); ROT();
    STEP(pA0,pA1,pB0,pB1,t+1,true,true,true);   WAIT_BAR(2); RESC(); ROT();
  }
  #undef CMASK
  #define CMASK(P0,P1,t) do{}while(0)
  #define ENDW(tt) do{ if((tt)+3<NT){WAIT_BAR(2);} else if((tt)+2<NT){WAIT_BAR(1);} else {WAIT_BAR(0);} }while(0)
  for(;t+1<NT;t+=2){
    STEP(pB0,pB1,pA0,pA1,t,(t+3<NT),(t+1<NT),(t+1<NT));       ENDW(t);   RESC(); ROT();
    STEP(pA0,pA1,pB0,pB1,t+1,(t+4<NT),(t+2<NT),(t+2<NT));     ENDW(t+1); RESC(); ROT();
  }
  STEP(pB0,pB1,pA0,pA1,NT-1,false,false,false); RESC();
  { float sacc=pB0[0]+pB0[1]; _Pragma("unroll") for(int r=2;r<16;++r)sacc+=pB0[r]; _Pragma("unroll") for(int r=0;r<16;++r)sacc+=pB1[r]; l_reg+=sacc;
    pw0=(u32x4){PKW(pB0,0),PKW(pB0,2),PKW(pB0,4),PKW(pB0,6)};pw1=(u32x4){PKW(pB0,8),PKW(pB0,10),PKW(pB0,12),PKW(pB0,14)};pw2=(u32x4){PKW(pB1,0),PKW(pB1,2),PKW(pB1,4),PKW(pB1,6)};pw3=(u32x4){PKW(pB1,8),PKW(pB1,10),PKW(pB1,12),PKW(pB1,14)};
    SBAR(); pv(o,vb0+sl_cur,PAF(0),PAF(1),PAF(2),PAF(3)); }
  #undef PKW
  #undef PAF
  #undef VFR
  #undef PIN
  #undef MX3
  #undef GAPA
  #undef GAPB
  #undef EX
  #undef VRD
  #undef KRD
  #undef STEP
  #undef ENDW
  {auto rr=__builtin_amdgcn_permlane32_swap(__float_as_uint(l_reg),__float_as_uint(l_reg),false,false);l_reg=__uint_as_float(rr[0])+__uint_as_float(rr[1]);}
  if(hi==0)wsf[32+r32]=l_reg;asm volatile("s_waitcnt lgkmcnt(0)":::"memory");
  float rli[16];
  #pragma unroll
  for(int r=0;r<16;++r)rli[r]=__builtin_amdgcn_rcpf(wsf[32+crow(r,hi)]);
  bf16*Ow=O+(rowbase+q0+wid*QBLK)*OP+OCOL0+h*D;
  { bf16*stg=(bf16*)(shm+LDS_OST)+wid*2048;
    #pragma unroll
    for(int r=0;r<16;++r){const int orow=crow(r,hi);
      #pragma unroll
      for(int d0=0;d0<2;++d0)stg[orow*64+d0*32+r32]=__float2bfloat16(o[d0][r]*rli[r]);}
    asm volatile("s_waitcnt lgkmcnt(0)":::"memory");
    #pragma unroll
    for(int i=0;i<4;++i){const int row=i*8+(lane>>3),ch=lane&7; const u32x4 v=*(const u32x4*)(stg+row*64+ch*8); ATTN_STORE16(Ow+(long)row*OP+ch*8,v);} }
  asm volatile("s_waitcnt lgkmcnt(0)\n\ts_barrier":::"memory");
  #undef DMA_K
  #undef DMA_V
  #undef CMASK
  #undef START
  #undef RESC
  #undef ROT
}
constexpr int ATTN_LDS_BYTES=LDS_BYTES;
struct AttnTensors { const bf16* Q; const bf16* K; const bf16* V; bf16* O; };
struct AttnUnit { int b; int h; int qb; };
struct StaticOrder {
  int vcu,per;
  __device__ __forceinline__ explicit StaticOrder(int grid,int block):vcu((grid%8==0)?(block%8)*(grid/8)+block/8:block),per((1024+grid-1)/grid){}
  __device__ __forceinline__ bool next(int i,AttnUnit&u)const{ const int id=vcu*per+i; if(i>=per||id>=1024)return false; u.b=id>>7; u.h=(id>>4)&7; u.qb=id&15; return true; }
  __device__ __forceinline__ void a_ready(const AttnUnit&)const{}
  __device__ __forceinline__ void done(const AttnUnit&)const{}
};
template<class Sched,int THRL=8> __device__ __forceinline__ void attn_phase(char*lds,const AttnTensors&T,const Sched&S){
  AttnUnit u;
  for(int i=0;S.next(i,u);++i){ S.a_ready(u); attn_unit<THRL>(u.b,u.h,u.qb,T.Q,T.K,T.V,T.O,lds); S.done(u); }
}
#undef SBAR
#undef WAIT_BAR
}
#include <hip/hip_cooperative_groups.h>
namespace cg = cooperative_groups;

#define GAS __attribute__((address_space(1)))
#define LAS __attribute__((address_space(3)))
typedef unsigned short bf16;
typedef unsigned v4u __attribute__((ext_vector_type(4)));
typedef unsigned v2u __attribute__((ext_vector_type(2)));
typedef float f32x4 __attribute__((ext_vector_type(4)));
typedef float f32x16 __attribute__((ext_vector_type(16)));
typedef short bf16x8 __attribute__((ext_vector_type(8)));
#define LDS_WAIT() asm volatile("s_waitcnt lgkmcnt(0)" ::: "memory")

constexpr int NWAVES = 8;
constexpr int NB = 8, SEQL = 4096, DMODEL = 1024, CTXL = 256, DIN = 2816, DFF = 4096;
constexpr int MLAT = NB * SEQL, MCTX = NB * CTXL, MALL = MLAT + MCTX;
constexpr int NCH = 34;
constexpr float RMS_EPS = 1e-6f;

constexpr size_t KiB = 1024, MiB = 1u << 20;
constexpr size_t WS_ROWSS = 0, WS_BIAS2 = 512 * KiB, WS_BAR = 1 * MiB, BAR_BYTES = 16 * KiB, WS_MOD = WS_BAR + BAR_BYTES, ZERO_BYTES = BAR_BYTES + 224 * KiB;
constexpr size_t WS_WIN = 2 * MiB, WS_WOUT = 8 * MiB, WS_W1 = 10 * MiB, WS_W2 = 18 * MiB;
constexpr size_t WS_H = 444 * MiB;
constexpr size_t WS_U = 32 * MiB;
constexpr size_t WS_MIX = 32 * MiB;
constexpr size_t WS_A2 = 96 * MiB;
constexpr size_t WS_HB = 168 * MiB;
constexpr size_t WS_RQ = 168 * MiB, WS_RK = 200 * MiB, WS_RV = 234 * MiB, WS_RG = 268 * MiB, WS_AQ = 300 * MiB, WS_KB = 332 * MiB, WS_VB = 341 * MiB, WS_S = 350 * MiB;
constexpr size_t WS_D1 = 424 * MiB;
constexpr size_t WS_END = 512 * MiB;
constexpr size_t WS_PROBE = 1 * MiB + 512 * KiB;
constexpr size_t WS_ROWSS2 = 128 * KiB, WS_CNT2 = 768 * KiB;
static_assert(WS_H + (size_t)MALL * DMODEL * 2 <= WS_END && WS_D1 + (size_t)MLAT * DMODEL * 2 <= WS_END && WS_U + (size_t)NB * 4 * NCH * 2 * 65536 <= WS_HB && WS_S + (size_t)NB * 4 * 32 * 2 * 32768 <= WS_END && WS_VB + (size_t)NB * 4352 * 128 * 2 <= WS_S, "d_ws map");

constexpr int LDS_BYTES = 147456;

__device__ __forceinline__ float wave_sum(float v) {
#pragma unroll
    for (int o = 1; o < 64; o <<= 1) v += __shfl_xor(v, o);
    return v;
}
typedef float f32x2_t_ __attribute__((ext_vector_type(2))); typedef __bf16 bf16x2_t_ __attribute__((ext_vector_type(2)));
__device__ __forceinline__ unsigned pk2(float lo, float hi) { f32x2_t_ v = {lo, hi}; return __builtin_bit_cast(unsigned, __builtin_convertvector(v, bf16x2_t_)); }
__device__ __forceinline__ unsigned f2bf(float f) { return pk2(f, 0.f) & 0xffffu; }
__device__ __forceinline__ float bf2f(unsigned short h) { return __builtin_bit_cast(float, (unsigned)h << 16); }

__host__ __device__ __forceinline__ int in_rowmap(int o) {
    const int tile = o >> 8, w = o & 255;
    if (tile < 4) { const int hl = w >> 7, d = w & 127; return tile * 256 + 128 * (d >> 6) + 32 * (2 * hl + ((d & 63) >> 5)) + (d & 31); }
    if (tile < 8) return o;
    const int hl = w >> 6, d = w & 63; return tile * 256 + 128 * (d >> 5) + 32 * hl + (d & 31);
}
template <bool PERMUTE> __device__ __forceinline__ void p0_transpose_item(const float* W, int K, int N, bf16* WT, LAS float* scr, int item, int lane) {
    const int nblk = N / 32, kb = item / nblk, nb = item % nblk, k0 = 64 * kb, n0 = 32 * nb;
    float tv[32];
#pragma unroll
    for (int i = 0; i < 32; ++i) tv[i] = __builtin_nontemporal_load(W + (size_t)(k0 + 2 * i + (lane >> 5)) * N + n0 + (lane & 31));
#pragma unroll
    for (int i = 0; i < 32; ++i) scr[(2 * i + (lane >> 5)) * 33 + (lane & 31)] = tv[i];
    LDS_WAIT(); asm volatile("" ::: "memory");
    const int c = lane & 7; const int r0 = PERMUTE ? in_rowmap(n0) : n0;
#pragma unroll
    for (int j = 0; j < 4; ++j) { const int n = (lane >> 3) + 8 * j; const LAS float* s = scr + (8 * c) * 33 + n;
        v4u o; o.x = pk2(s[0 * 33], s[1 * 33]); o.y = pk2(s[2 * 33], s[3 * 33]); o.z = pk2(s[4 * 33], s[5 * 33]); o.w = pk2(s[6 * 33], s[7 * 33]);
        *(GAS v4u*)(WT + (size_t)(r0 + n) * K + k0 + 8 * c) = o; }
    LDS_WAIT(); asm volatile("" ::: "memory");
}

__device__ __forceinline__ int sw_off(int r, int c) { return r * 256 + ((((c >> 3) ^ (r & 15)) << 4) | ((c & 7) << 1)); }
template <int NT> __device__ __forceinline__ void lds_mma(f32x16 (&acc)[NT], const LAS unsigned char* A, int arow0, const LAS unsigned char* B, int brow0, int lane) {
    const int r32 = lane & 31, hi = lane >> 5, sw = r32 & 15;
    const LAS unsigned char* ap = A + (arow0 + r32) * 256; const LAS unsigned char* bp = B + (brow0 + r32) * 256;
#pragma unroll
    for (int k0 = 0; k0 < 8; ++k0) { const int ch = ((2 * k0 + hi) ^ sw) << 4;
        const bf16x8 a = *(const LAS bf16x8*)(ap + ch);
#pragma unroll
        for (int nt = 0; nt < NT; ++nt) { const bf16x8 b = *(const LAS bf16x8*)(bp + nt * 32 * 256 + ch); acc[nt] = __builtin_amdgcn_mfma_f32_32x32x16_bf16(a, b, acc[nt], 0, 0, 0); } }
}
__device__ __forceinline__ int imgb_off(int row, int ch) { return 256 * row + 16 * (ch ^ (((row & 3) << 2) | ((row >> 2) & 3))); }
__device__ __forceinline__ bf16x8 frag_row(const LAS unsigned char* img, int row0, int lane, int s) { return *(const LAS bf16x8*)(img + imgb_off(row0 + (lane & 31), 2 * s + (lane >> 5))); }
typedef short v4i16_t __attribute__((ext_vector_type(4)));
__device__ __forceinline__ bf16x8 frag_tr(const LAS unsigned char* img, int c, int lane, int ks) {
    const int h = lane >> 5, blk = (lane >> 4) & 1, q = (lane & 15) >> 2, p = lane & 3, r0 = 16 * ks + 8 * h + q, ch = 4 * c + 2 * blk + (p >> 1);
    const v4i16_t lo = __builtin_amdgcn_ds_read_tr16_b64_v4i16((LAS v4i16_t*)(img + imgb_off(r0, ch) + 8 * (p & 1)));
    const v4i16_t hi = __builtin_amdgcn_ds_read_tr16_b64_v4i16((LAS v4i16_t*)(img + imgb_off(r0 + 4, ch) + 8 * (p & 1)));
    return (bf16x8){lo[0], lo[1], lo[2], lo[3], hi[0], hi[1], hi[2], hi[3]};
}
__device__ __forceinline__ bf16x8 frag16_row(const LAS unsigned char* img, int rb, int lane, int s) { return *(const LAS bf16x8*)(img + imgb_off((lane & 15) + 16 * rb, 4 * s + (lane >> 4))); }
__device__ __forceinline__ bf16x8 frag16_tr_perm(const LAS unsigned char* img, int c, int lane, int s) {
    const int g = lane >> 4, q = (lane & 15) >> 2, p = lane & 3, r0 = 32 * s + 4 * g + q, ch = 2 * c + (p >> 1);
    const v4i16_t lo = __builtin_amdgcn_ds_read_tr16_b64_v4i16((LAS v4i16_t*)(img + imgb_off(r0, ch) + 8 * (p & 1)));
    const v4i16_t hi = __builtin_amdgcn_ds_read_tr16_b64_v4i16((LAS v4i16_t*)(img + imgb_off(r0 + 16, ch) + 8 * (p & 1)));
    return (bf16x8){lo[0], lo[1], lo[2], lo[3], hi[0], hi[1], hi[2], hi[3]};
}
__device__ __forceinline__ int crow16(int r, int hi) { return (r & 3) + 8 * (r >> 2) + 4 * hi; }
__device__ __forceinline__ void stage_copy(LAS unsigned char* dst, const bf16* src, int pitch, int tid) {
#pragma unroll
    for (int i = 0; i < 4; ++i) { const int idx = tid + i * 512, r = idx >> 4, ch = idx & 15;
        const v4u v = *(const GAS v4u*)(src + (size_t)r * pitch + ch * 8); *(LAS v4u*)(dst + r * 256 + ((ch ^ (r & 15)) << 4)) = v; }
}
template <bool TWO> __device__ __forceinline__ void stage_transpose(LAS unsigned char* dst, LAS unsigned char* dst2, const bf16* src, int pitch, int tid, float l2a, float offa, float l2b, float offb, bool weighted) {
#pragma unroll
    for (int i = 0; i < 4; ++i) { const int idx = tid + i * 512, r = idx >> 4, ch = idx & 15;
        const v4u v = *(const GAS v4u*)(src + (size_t)r * pitch + ch * 8);
        const float wa = weighted ? __builtin_amdgcn_exp2f(l2a * ((float)r + offa)) : 1.0f;
        const float wb = TWO ? __builtin_amdgcn_exp2f(l2b * ((float)r + offb)) : 1.0f;
        const unsigned wv[4] = {v.x, v.y, v.z, v.w};
#pragma unroll
        for (int e = 0; e < 8; ++e) { const unsigned short hb = (unsigned short)((wv[e >> 1] >> ((e & 1) * 16)) & 0xffffu); const int c = ch * 8 + e;
            if (weighted) { const float f = bf2f(hb); *(LAS unsigned short*)(dst + sw_off(c, r)) = (unsigned short)f2bf(f * wa); if (TWO) *(LAS unsigned short*)(dst2 + sw_off(c, r)) = (unsigned short)f2bf(f * wb); }
            else *(LAS unsigned short*)(dst + sw_off(c, r)) = hb; } }
}

#define RLX_AGENT __ATOMIC_RELAXED, __HIP_MEMORY_SCOPE_AGENT
#define XB_TMO      128
#define XB_XCNT(j)  (256  + 64 * (j))
#define XB_XSUB(j)  (1280 + 64 * (j))
#define XB_XGEN(j)  (2304 + 64 * (j))
#define XB_TOP      3328
#define XB_TOPGEN   3392
#define XCD_BAR_WORDS 3456
#define XB_SPIN_CAP (1u << 18)

__device__ __forceinline__ unsigned xb_ld(unsigned* p)              { return __hip_atomic_load(p, __ATOMIC_RELAXED, __HIP_MEMORY_SCOPE_AGENT); }
__device__ __forceinline__ unsigned xb_add(unsigned* p, unsigned v) { return __hip_atomic_fetch_add(p, v, __ATOMIC_RELAXED, __HIP_MEMORY_SCOPE_AGENT); }
__device__ __forceinline__ unsigned xb_xcc_id() { return (unsigned)__builtin_amdgcn_s_getreg((3 << 11) | 20) & 0xFu; }
#define XB_SPIN(cond, bar) do { unsigned _sp = 0; while (cond) { __builtin_amdgcn_s_sleep(1); \
    if ((++_sp & 255u) == 0u) { if (xb_ld(&(bar)[XB_TMO])) break; if (_sp > XB_SPIN_CAP) { atomicAdd(&(bar)[XB_TMO], 1u); break; } } } } while (0)

struct XcdBarrier {
    unsigned* bar; unsigned x;
    volatile LAS unsigned* st;
};

__device__ __forceinline__ XcdBarrier xcd_barrier_post(unsigned* bar, volatile LAS unsigned* st) {
    XcdBarrier b; b.bar = bar; b.x = xb_xcc_id(); b.st = st;
    if (threadIdx.x == 0) (void)xb_add(&bar[XB_XCNT(b.x)], 1u);
    return b;
}
__device__ __forceinline__ void xcd_barrier_complete(unsigned* bar, unsigned x, unsigned& nloc, unsigned& nx) {
    const unsigned G = gridDim.x * gridDim.y * gridDim.z;
    unsigned sum, cnt, mine, sp = 0u;
    for (;;) {
        sum = 0u; cnt = 0u; mine = 0u;
#pragma unroll
        for (unsigned j = 0; j < 16; ++j) { const unsigned c = xb_ld(&bar[XB_XCNT(j)]); sum += c; cnt += (c > 0u) ? 1u : 0u; mine = (j == x) ? c : mine; }
        if (sum == G) break;
        __builtin_amdgcn_s_sleep(1);
        if ((++sp & 255u) == 0u) { if (xb_ld(&bar[XB_TMO])) break; if (sp > XB_SPIN_CAP) { atomicAdd(&bar[XB_TMO], 1u); break; } }
    }
    nloc = mine > 0u ? mine : 1u; nx = cnt > 0u ? cnt : 1u;
}

__device__ __forceinline__ void xcd_barrier(const XcdBarrier& b) {
    asm volatile("s_waitcnt vmcnt(0)" ::: "memory");
    __syncthreads();
    if (threadIdx.x == 0) {
        unsigned* bar = b.bar;
        __builtin_amdgcn_s_waitcnt(0);
        unsigned nloc = b.st[0], nx = b.st[1];
        if (nloc == 0u) { xcd_barrier_complete(bar, b.x, nloc, nx); b.st[0] = nloc; b.st[1] = nx; }
        const unsigned old = xb_add(&bar[XB_XSUB(b.x)], 1u);
        const unsigned gen = old / nloc;
        if (old + 1u == (gen + 1u) * nloc) {
            __builtin_amdgcn_fence(__ATOMIC_RELEASE, "agent");
            asm volatile("s_waitcnt vmcnt(0)" ::: "memory");
            const unsigned og = xb_add(&bar[XB_TOP], 1u);
            const unsigned tg = og / nx;
            if (og + 1u == (tg + 1u) * nx) xb_add(&bar[XB_TOPGEN], 1u);
            else XB_SPIN(xb_ld(&bar[XB_TOPGEN]) == tg, bar);
            __builtin_amdgcn_fence(__ATOMIC_ACQUIRE, "agent");
            xb_add(&bar[XB_XGEN(b.x)], 1u);
            asm volatile("s_waitcnt vmcnt(0)" ::: "memory");
        } else {
            XB_SPIN(xb_ld(&bar[XB_XGEN(b.x)]) == gen, bar);
            __builtin_amdgcn_fence(__ATOMIC_ACQUIRE, "agent");
            asm volatile("s_waitcnt vmcnt(0)" ::: "memory");
        }
    }
    __syncthreads();
}
#ifndef REP_PRE
#define REP_PRE 1
#endif
#ifndef REP_P2
#define REP_P2 1
#endif
#ifndef REP_RET
#define REP_RET 1
#endif
#ifndef REP_ATT
#define REP_ATT 1
#endif
#ifndef REP_P7
#define REP_P7 1
#endif
#ifndef REP_P3
#define REP_P3 1
#endif
#ifndef REP_P5A
#define REP_P5A 1
#endif
#ifndef REP_P0
#define REP_P0 1
#endif
#ifndef REP_P6
#define REP_P6 1
#endif
#ifndef REP_P8
#define REP_P8 1
#endif
struct Args { const float* in[17]; float* out; unsigned char* ws; };
#define CAS __attribute__((address_space(4)))
#define PHASE_PTRS() \
    const CAS unsigned char* kp_ = (const CAS unsigned char*)__builtin_amdgcn_kernarg_segment_ptr(); asm volatile("" : "+s"(kp_)); \
    const CAS Args* ka_ = (const CAS Args*)kp_; unsigned char* ws = ka_->ws; (void)ws; \
    const float *x = ka_->in[0], *cvec = ka_->in[1], *ctxp = ka_->in[2], *c_ctx = ka_->in[3], *w_mod = ka_->in[4], *b_mod = ka_->in[5], *n1g = ka_->in[6], *n2g = ka_->in[7], \
                *w_in = ka_->in[8], *w_out = ka_->in[9], *ret_rate = ka_->in[10], *ret_gn = ka_->in[11], *qng = ka_->in[12], *kng = ka_->in[13], *w_ff1 = ka_->in[14], *w_ff2 = ka_->in[15], *fng = ka_->in[16]; \
    float* out = ka_->out; \
    float* rowss = (float*)(ws + WS_ROWSS); float* MOD = (float*)(ws + WS_MOD); float* BIAS2 = (float*)(ws + WS_BIAS2); \
    bf16 *Win_t = (bf16*)(ws + WS_WIN), *Wout_t = (bf16*)(ws + WS_WOUT), *W1_t = (bf16*)(ws + WS_W1), *W2_t = (bf16*)(ws + WS_W2); \
    bf16 *H = (bf16*)(ws + WS_H), *MIX = (bf16*)(ws + WS_MIX), *A2 = (bf16*)(ws + WS_A2), *HB = (bf16*)(ws + WS_HB); \
    bf16 *RQ = (bf16*)(ws + WS_RQ), *RK = (bf16*)(ws + WS_RK), *RV = (bf16*)(ws + WS_RV), *RG = (bf16*)(ws + WS_RG), *AQ = (bf16*)(ws + WS_AQ), *KB = (bf16*)(ws + WS_KB), *VB = (bf16*)(ws + WS_VB), *SB = (bf16*)(ws + WS_S); \
    float* rowss2 = (float*)(ws + WS_ROWSS2); unsigned* cnt2 = (unsigned*)(ws + WS_CNT2); bf16* D1 = (bf16*)(ws + WS_D1); (void)rowss2; (void)cnt2; (void)D1; \
    float* U = (float*)(ws + WS_U); \
    (void)x; (void)cvec; (void)ctxp; (void)c_ctx; (void)w_mod; (void)b_mod; (void)n1g; (void)n2g; (void)w_in; (void)w_out; (void)ret_rate; (void)ret_gn; (void)qng; (void)kng; (void)w_ff1; (void)w_ff2; (void)fng; (void)out; \
    (void)rowss; (void)MOD; (void)BIAS2; (void)Win_t; (void)Wout_t; (void)W1_t; (void)W2_t; (void)H; (void)MIX; (void)A2; (void)HB; (void)RQ; (void)RK; (void)RV; (void)RG; (void)AQ; (void)KB; (void)VB; (void)SB; (void)U;


__global__ void __launch_bounds__(NWAVES * 64, 2) fwd_megakernel(Args args) {
    extern __shared__ __attribute__((aligned(16))) unsigned char lds_raw[];
    LAS unsigned char* lds = (LAS unsigned char*)lds_raw;
    cg::grid_group grid = cg::this_grid();
    if (args.ws == nullptr) grid.sync();
    { volatile LAS unsigned* st0 = (volatile LAS unsigned*)(lds + LDS_BYTES - 64); if (threadIdx.x < 16) st0[threadIdx.x] = 0u; }
    __syncthreads();
    const XcdBarrier gbar = xcd_barrier_post((unsigned*)(args.ws + WS_BAR), (volatile LAS unsigned*)(lds + LDS_BYTES - 64));
#define GRID_SYNC() xcd_barrier(gbar)
    const int tid = threadIdx.x, lane = tid & 63, wave = __builtin_amdgcn_readfirstlane(tid >> 6);
    const int G = gridDim.x, bx = blockIdx.x, vcu = (G % 8 == 0) ? (bx % 8) * (G / 8) + bx / 8 : bx;
    const int gw = vcu * NWAVES + wave, NGW = G * NWAVES;

    for (int rep_ = 0; rep_ < REP_PRE; ++rep_) {
    for (int rp0_ = 0; rp0_ < REP_P0; ++rp0_) {
#ifndef SKIP_P0
    {
        PHASE_PTRS();
        for (int i = bx * 512 + tid; i < MLAT; i += G * 512) { rowss[i] = 0.f; rowss2[i] = 0.f; if (i < 128 * 64) cnt2[i] = 0u; }
#if REP_P6 > 1 || REP_P8 > 1
        for (int i = bx * 512 + tid; i < MLAT; i += G * 512) { ((float*)(ws + WS_PROBE))[i] = 0.f; ((float*)(ws + WS_PROBE))[MLAT + i] = 0.f; if (i < 128 * 64) ((unsigned*)(ws + WS_PROBE))[2 * MLAT + i] = 0u; }
#endif
        if (vcu < 192) {
            const int cgp = vcu % 96, kh = vcu / 96;
            LAS float* cact = (LAS float*)(lds + 73728);
            LAS float* red = (LAS float*)(lds + 73728 + 36864);
            const int col = cgp * 64 + lane; float wv[64];
#pragma unroll
            for (int i = 0; i < 64; ++i) wv[i] = __builtin_nontemporal_load(w_mod + (size_t)(kh * 512 + wave * 64 + i) * 6144 + col);
            for (int i = tid; i < 9 * 512; i += 512) { const int b = i >> 9, k = kh * 512 + (i & 511); const float v = (b < 8) ? cvec[b * 1024 + k] : c_ctx[k]; cact[i] = v * __builtin_amdgcn_rcpf(1.0f + __builtin_amdgcn_exp2f(-v * 1.4426950408889634f)); }
            __syncthreads();
            float a9[9];
#pragma unroll
            for (int b = 0; b < 9; ++b) a9[b] = 0.f;
#pragma unroll
            for (int i = 0; i < 64; i += 4)
#pragma unroll
                for (int b = 0; b < 9; ++b) { const f32x4 cv = *(const LAS f32x4*)(cact + b * 512 + wave * 64 + i); a9[b] += cv[0] * wv[i] + cv[1] * wv[i + 1] + cv[2] * wv[i + 2] + cv[3] * wv[i + 3]; }
#pragma unroll
            for (int b = 0; b < 9; ++b) red[(wave * 9 + b) * 64 + lane] = a9[b];
            __syncthreads();
            for (int i = tid; i < 576; i += 512) { const int b = i >> 6, l = i & 63; float s = kh ? 0.f : b_mod[cgp * 64 + l];
#pragma unroll
                for (int w = 0; w < 8; ++w) s += red[(w * 9 + b) * 64 + l];
                atomicAdd(MOD + b * 6144 + cgp * 64 + l, s); }
            __syncthreads();
        }
        LAS float* scr = (LAS float*)(lds + wave * 9216);
        constexpr int I_IN = (DMODEL / 64) * (DIN / 32);
        for (int it = gw; it < I_IN; it += NGW) p0_transpose_item<true>(w_in, DMODEL, DIN, Win_t, scr, it, lane);
    }
#endif
    }
    GRID_SYNC();

#ifndef SKIP_P1
    {
        PHASE_PTRS();
        {
            const int rpw = (MALL + NGW - 1) / NGW, m0 = gw * rpw, m1 = (m0 + rpw < MALL) ? m0 + rpw : MALL;
            f32x4 ca[4], cb[4], v[4], nx[4], nx2[4]; int cur = -1;
#define P1_SRC(m_) (((m_) < MLAT) ? x + (size_t)(m_) * 1024 : ctxp + (size_t)((m_) - MLAT) * 1024)
            if (m0 < m1) { const float* src = P1_SRC(m0);
#pragma unroll
                for (int j = 0; j < 4; ++j) nx[j] = __builtin_nontemporal_load((const GAS f32x4*)(src + 256 * j + 4 * lane)); }
            if (m0 + 1 < m1) { const float* src = P1_SRC(m0 + 1);
#pragma unroll
                for (int j = 0; j < 4; ++j) nx2[j] = __builtin_nontemporal_load((const GAS f32x4*)(src + 256 * j + 4 * lane)); }
            for (int m = m0; m < m1; ++m) {
#pragma unroll
                for (int j = 0; j < 4; ++j) { v[j] = nx[j]; nx[j] = nx2[j]; }
                if (m + 2 < m1) { const float* src = P1_SRC(m + 2);
#pragma unroll
                    for (int j = 0; j < 4; ++j) nx2[j] = __builtin_nontemporal_load((const GAS f32x4*)(src + 256 * j + 4 * lane)); }
                const int bidx = (m < MLAT) ? (m >> 12) : 8;
                if (bidx != cur) { cur = bidx; const float* mb = MOD + (size_t)bidx * 6144;
#pragma unroll
                    for (int j = 0; j < 4; ++j) { const int k = 256 * j + 4 * lane; const f32x4 g = *(const f32x4*)(n1g + k), sh = *(const f32x4*)(mb + k), sc = *(const f32x4*)(mb + 1024 + k); ca[j] = g * (sc + 1.0f); cb[j] = sh; } }
                float s = 0.f;
#pragma unroll
                for (int j = 0; j < 4; ++j) s += (v[j][0] * v[j][0] + v[j][1] * v[j][1]) + (v[j][2] * v[j][2] + v[j][3] * v[j][3]);
                const float rstd = 1.0f / sqrtf(wave_sum(s) * (1.0f / 1024.0f) + RMS_EPS);
#pragma unroll
                for (int j = 0; j < 4; ++j) { const f32x4 y = (v[j] * rstd) * ca[j] + cb[j]; v2u o; o.x = pk2(y[0], y[1]); o.y = pk2(y[2], y[3]);
                    *(GAS v2u*)(H + (size_t)m * 1024 + 256 * j + 4 * lane) = o; }
            }
        }
    }
#endif
    if (rep_ + 1 < REP_PRE) GRID_SYNC(); }
    GRID_SYNC();

    for (int rep_ = 0; rep_ < REP_P2; ++rep_) {
#ifndef SKIP_P2
    {
        PHASE_PTRS();
        pg8::Gemm g{H, Win_t, MALL, DIN, DMODEL}; pg8::StaticOrder S; S.init(MALL, DIN, G, bx);
        pg8::EpiIn E{RQ, RK, RV, RG, AQ, KB, VB, qng, kng};
        pg8::gemm_phase<pg8::EpiIn, pg8::StaticOrder, PG8_ALIGN, PG8_SP2>(lds, g, S, E);
    }
#endif
    }
    GRID_SYNC();

    {
    const attn_body::StaticOrder AS(G, bx); const int pslot = vcu & 1, ahalf = AS.per / 2;
#pragma unroll
    for (int slot = 0; slot < 2; ++slot) {
    if (slot == pslot) {
#ifndef SKIP_P3
    {
        PHASE_PTRS();
        for (int rp3_ = 0; rp3_ < REP_P3; ++rp3_)
        for (int task = vcu; task < 256; task += G) {
            int tid = threadIdx.x; asm volatile("" : "+v"(tid)); const int lane = tid & 63;
            const int bh = task >> 3, dir = (task >> 2) & 1, vq = task & 3, b = bh >> 2, h = bh & 3;
            const float lg2 = log1pf(-expf(ret_rate[dir * 4 + h])) * 1.4426950408889634f; const float Gd = __builtin_amdgcn_exp2f(lg2 * 128.0f);
            const int vr = tid >> 2, vch = tid & 3;
            const float wv = __builtin_amdgcn_exp2f(lg2 * (float)(dir ? vr : 127 - vr));
            v4u kregA[4], vregA, kregB[4], vregB;
            auto row0_of = [&](int s_) -> size_t { if (s_ < 2) { const int q = dir ? 1 - s_ : s_; return (size_t)MLAT + b * CTXL + q * 128; } const int c = dir ? 33 - s_ : s_ - 2; return (size_t)b * SEQL + c * 128; };
#define P3_LOAD(KR, VR, s_) do { const size_t r0_ = row0_of(s_); _Pragma("unroll") for (int i = 0; i < 4; ++i) { const int idx = tid + i * 512; KR[i] = *(const GAS v4u*)(RK + (r0_ + (idx >> 4)) * 512 + h * 128 + (idx & 15) * 8); } \
                VR = *(const GAS v4u*)(RV + (r0_ + vr) * 512 + h * 128 + vq * 32 + vch * 8); } while (0)
#define P3_LBAR() asm volatile("s_waitcnt lgkmcnt(0)\n\ts_barrier" ::: "memory")
#define P3_STEP(KR, VR, s_) do { \
                LAS unsigned char* Kimg = lds + ((s_) & 1) * 65536; LAS unsigned char* Vimg = Kimg + 32768; \
                _Pragma("unroll") for (int i = 0; i < 4; ++i) { const int idx = tid + i * 512; *(LAS v4u*)(Kimg + imgb_off(idx >> 4, idx & 15)) = KR[i]; } \
                { const unsigned vu[4] = {VR.x, VR.y, VR.z, VR.w}; v4u o; \
                  o.x = pk2(__builtin_bit_cast(float, vu[0] << 16) * wv, __builtin_bit_cast(float, vu[0] & 0xffff0000u) * wv); o.y = pk2(__builtin_bit_cast(float, vu[1] << 16) * wv, __builtin_bit_cast(float, vu[1] & 0xffff0000u) * wv); \
                  o.z = pk2(__builtin_bit_cast(float, vu[2] << 16) * wv, __builtin_bit_cast(float, vu[2] & 0xffff0000u) * wv); o.w = pk2(__builtin_bit_cast(float, vu[3] << 16) * wv, __builtin_bit_cast(float, vu[3] & 0xffff0000u) * wv); \
                  *(LAS v4u*)(Vimg + imgb_off(vr, vch)) = o; } \
                if ((s_) + 2 < 34) P3_LOAD(KR, VR, (s_) + 2); \
                P3_LBAR(); \
                if (wave < 4) { \
                    const int r32 = lane & 31, hi = lane >> 5; \
                    if ((s_) >= 2) { const int c = dir ? 33 - (s_) : (s_) - 2; bf16* sp = SB + ((size_t)(bh * 32 + c) * 2 + dir) * 16384 + (size_t)(vq * 32) * 128 + wave * 32 + r32; \
                        _Pragma("unroll") for (int r = 0; r < 16; ++r) sp[crow16(r, hi) * 128] = (bf16)f2bf(acc[r]); } \
                    if ((s_) < 33) { \
                        _Pragma("unroll") for (int r = 0; r < 16; ++r) acc[r] *= Gd; \
                        _Pragma("unroll") for (int ks = 0; ks < 8; ++ks) acc = __builtin_amdgcn_mfma_f32_32x32x16_bf16(frag_tr(Vimg, 0, lane, ks), frag_tr(Kimg, wave, lane, ks), acc, 0, 0, 0); \
                    } \
                } } while (0)
            P3_LOAD(kregA, vregA, 0); P3_LOAD(kregB, vregB, 1);
            f32x16 acc = f32x16{};
            for (int s_ = 0; s_ < 34; s_ += 2) { P3_STEP(kregA, vregA, s_); P3_STEP(kregB, vregB, s_ + 1); }
            P3_LBAR();
#undef P3_LOAD
#undef P3_STEP
#undef P3_LBAR
        }
    }
#endif
    {
        PHASE_PTRS();
        int tid = threadIdx.x; asm volatile("" : "+v"(tid)); const int lane = tid & 63;
        LAS float* scr = (LAS float*)(lds + wave * 9216);
        constexpr int I_OUT = (DMODEL / 64) * (DMODEL / 32), I_1 = (DMODEL / 64) * (DFF / 32), I_2 = (DFF / 64) * (DMODEL / 32);
        for (int it = gw; it < I_OUT + I_1 + I_2; it += NGW) {
            int r = it;
            if (r < I_OUT) { p0_transpose_item<false>(w_out, DMODEL, DMODEL, Wout_t, scr, r, lane); continue; } r -= I_OUT;
            if (r < I_1) { p0_transpose_item<false>(w_ff1, DMODEL, DFF, W1_t, scr, r, lane); continue; } r -= I_1;
            p0_transpose_item<false>(w_ff2, DFF, DMODEL, W2_t, scr, r, lane);
        }
        __syncthreads();
    }
    }
    if (slot == 0) {
#ifndef SKIP_P5b
    {
        PHASE_PTRS();
        attn_body::AttnUnit u;
        for (int au = 0; au < ahalf && AS.next(au, u); ++au) attn_body::attn_unit<8>(u.b, u.h, u.qb, (const attn_body::bf16*)AQ, (const attn_body::bf16*)KB, (const attn_body::bf16*)VB, (attn_body::bf16*)MIX, (char*)lds_raw);
    }
#endif
    }
    }
    }
    GRID_SYNC();

    {
    const attn_body::StaticOrder AS(G, bx); const int pslot = vcu & 1, ahalf = AS.per / 2;
#pragma unroll
    for (int slot = 0; slot < 2; ++slot) {
    if (slot == pslot) {
#ifndef SKIP_P5a
    {
        PHASE_PTRS();
        LAS unsigned char* Ks = lds; LAS unsigned char* Vs = lds + 32768; LAS unsigned char* Fs = lds + 65536; LAS unsigned char* Bs = lds + 98304;
#define LBAR() asm volatile("s_waitcnt lgkmcnt(0)\n\ts_barrier" ::: "memory")
#define P5_LOAD(t_) do { const int bh_ = (t_) >> 5, c_ = (t_) & 31; const size_t r0_ = (size_t)(bh_ >> 2) * SEQL + c_ * 128; const int h_ = bh_ & 3; \
        _Pragma("unroll") for (int i = 0; i < 4; ++i) { const int idx = ptid + i * 512, r = idx >> 4, ch = idx & 15; const size_t go = (r0_ + r) * 512 + h_ * 128 + ch * 8; \
            kr_[i] = *(const GAS v4u*)(RK + go); vr_[i] = *(const GAS v4u*)(RV + go); fr_[i] = *(const GAS v4u*)(SB + ((size_t)(t_) * 2 + 0) * 16384 + r * 128 + ch * 8); br_[i] = *(const GAS v4u*)(SB + ((size_t)(t_) * 2 + 1) * 16384 + r * 128 + ch * 8); } \
        _Pragma("unroll") for (int s4 = 0; s4 < 4; ++s4) qn_[s4] = *(const GAS v4u*)(RQ + (r0_ + 16 * wave + (ptid & 15)) * 512 + h_ * 128 + 32 * s4 + 8 * ((ptid & 63) >> 4)); } while (0)
        v4u kr_[4], vr_[4], fr_[4], br_[4], qn_[4];
        { const int ptid = threadIdx.x; if (vcu < NB * 4 * 32) P5_LOAD(vcu); }
        for (int rp5_ = 0; rp5_ < REP_P5A; ++rp5_)
        for (int task = vcu; task < NB * 4 * 32; task += G) {
            const int bh = task >> 5, c = task & 31, b = bh >> 2, h = bh & 3;
            int tid = threadIdx.x; asm volatile("" : "+v"(tid)); const int lane = tid & 63; const int il = lane & 15, g4 = lane >> 4;
            const float lgf = log1pf(-expf(ret_rate[h])) * 1.4426950408889634f, lgb = log1pf(-expf(ret_rate[4 + h])) * 1.4426950408889634f;
            const size_t row0 = (size_t)b * SEQL + c * 128; const int irow = 16 * wave + il;
#pragma unroll
            for (int i = 0; i < 4; ++i) { const int idx = tid + i * 512, o = imgb_off(idx >> 4, idx & 15);
                *(LAS v4u*)(Ks + o) = kr_[i]; *(LAS v4u*)(Vs + o) = vr_[i]; *(LAS v4u*)(Fs + o) = fr_[i]; *(LAS v4u*)(Bs + o) = br_[i]; }
            bf16x8 qf[4];
#pragma unroll
            for (int s4 = 0; s4 < 4; ++s4) qf[s4] = __builtin_bit_cast(bf16x8, qn_[s4]);
            v2u gq[8];
#pragma unroll
            for (int vt = 0; vt < 8; ++vt) gq[vt] = *(const GAS v2u*)(RG + (row0 + irow) * 512 + h * 128 + 16 * vt + 4 * g4);
            { const int ptid = tid; const int nt_ = (task + G < NB * 4 * 32) ? task + G : vcu; P5_LOAD(nt_); }
            LBAR();
            f32x4 st[8];
#pragma unroll
            for (int t = 0; t < 8; ++t) { st[t] = (f32x4){0.f, 0.f, 0.f, 0.f};
#pragma unroll
                for (int s4 = 0; s4 < 4; ++s4) st[t] = __builtin_amdgcn_mfma_f32_16x16x32_bf16(frag16_row(Ks, t, lane, s4), qf[s4], st[t], 0, 0, 0); }
            bf16x8 pf[4];
#pragma unroll
            for (int s4 = 0; s4 < 4; ++s4) { unsigned pw[4];
#pragma unroll
                for (int hf = 0; hf < 2; ++hf) { const int t = 2 * s4 + hf; float wv[4];
#pragma unroll
                    for (int jj = 0; jj < 4; ++jj) { const int dlt = irow - (16 * t + 4 * g4 + jj); const float fd = (float)dlt; float w = __builtin_amdgcn_exp2f((dlt > 0) ? lgf * fd : -lgb * fd); w = (dlt == 0) ? 2.0f : w; wv[jj] = st[t][jj] * w; }
                    pw[2 * hf] = pk2(wv[0], wv[1]); pw[2 * hf + 1] = pk2(wv[2], wv[3]); }
                pf[s4] = __builtin_bit_cast(bf16x8, (v4u){pw[0], pw[1], pw[2], pw[3]}); }
            f32x4 ot[8];
#pragma unroll
            for (int vt = 0; vt < 8; ++vt) { ot[vt] = (f32x4){0.f, 0.f, 0.f, 0.f};
#pragma unroll
                for (int s4 = 0; s4 < 4; ++s4) ot[vt] = __builtin_amdgcn_mfma_f32_16x16x32_bf16(frag16_tr_perm(Vs, vt, lane, s4), pf[s4], ot[vt], 0, 0, 0); }
            { const float qfw = __builtin_amdgcn_exp2f(lgf * (float)(irow + 1)), qbw = __builtin_amdgcn_exp2f(lgb * (float)(128 - irow));
#pragma unroll
              for (int vt = 0; vt < 8; ++vt) { f32x4 t2 = (f32x4){0.f, 0.f, 0.f, 0.f}, t3 = (f32x4){0.f, 0.f, 0.f, 0.f};
#pragma unroll
                  for (int s4 = 0; s4 < 4; ++s4) { t2 = __builtin_amdgcn_mfma_f32_16x16x32_bf16(frag16_row(Fs, vt, lane, s4), qf[s4], t2, 0, 0, 0); t3 = __builtin_amdgcn_mfma_f32_16x16x32_bf16(frag16_row(Bs, vt, lane, s4), qf[s4], t3, 0, 0, 0); }
                  ot[vt] += t2 * qfw + t3 * qbw; } }
            { float sm = 0.f;
#pragma unroll
              for (int vt = 0; vt < 8; ++vt) sm += (ot[vt][0] + ot[vt][1]) + (ot[vt][2] + ot[vt][3]);
              sm += __shfl_xor(sm, 16); sm += __shfl_xor(sm, 32); const float mu = sm * (1.0f / 128.0f); float sq = 0.f;
#pragma unroll
              for (int vt = 0; vt < 8; ++vt) { ot[vt] = ot[vt] - mu; sq += (ot[vt][0] * ot[vt][0] + ot[vt][1] * ot[vt][1]) + (ot[vt][2] * ot[vt][2] + ot[vt][3] * ot[vt][3]); }
              sq += __shfl_xor(sq, 16); sq += __shfl_xor(sq, 32); const float rstd = 1.0f / sqrtf(sq * (1.0f / 128.0f) + RMS_EPS);
              const float* gn = ret_gn + h * 128 + 4 * g4; bf16* mp = MIX + (row0 + irow) * 1024 + h * 128 + 4 * g4;
#pragma unroll
              for (int vt = 0; vt < 8; ++vt) { const f32x4 n0 = *(const f32x4*)(gn + 16 * vt); const f32x4 a = ot[vt] * rstd * n0; const v2u gv = gq[vt];
                  v2u ov; ov.x = pk2(a[0] * __builtin_bit_cast(float, gv.x << 16), a[1] * __builtin_bit_cast(float, gv.x & 0xffff0000u)); ov.y = pk2(a[2] * __builtin_bit_cast(float, gv.y << 16), a[3] * __builtin_bit_cast(float, gv.y & 0xffff0000u));
                  *(GAS v2u*)(mp + 16 * vt) = ov; } }
            LBAR();
        }
#undef LBAR
#undef P5_LOAD
    }
#endif
    {
        PHASE_PTRS();
        int tid = threadIdx.x; asm volatile("" : "+v"(tid)); const int lane = tid & 63;
        for (int n = gw; n < DFF; n += NGW) {
            const v4u wa = *(const GAS v4u*)(W1_t + (size_t)n * 1024 + 8 * lane), wb = *(const GAS v4u*)(W1_t + (size_t)n * 1024 + 512 + 8 * lane);
            float wf[16]; const unsigned wu[8] = {wa.x, wa.y, wa.z, wa.w, wb.x, wb.y, wb.z, wb.w};
#pragma unroll
            for (int e = 0; e < 8; ++e) { wf[2 * e] = __builtin_bit_cast(float, wu[e] << 16); wf[2 * e + 1] = __builtin_bit_cast(float, wu[e] & 0xffff0000u); }
            float myv = 0.f;
#pragma unroll
            for (int b = 0; b < 8; ++b) { const float* sh2 = MOD + (size_t)b * 6144 + 3072; float s = 0.f;
#pragma unroll
                for (int hlf = 0; hlf < 2; ++hlf) { const f32x4 p = *(const f32x4*)(sh2 + 512 * hlf + 8 * lane), q = *(const f32x4*)(sh2 + 512 * hlf + 8 * lane + 4);
                    s += p[0] * wf[8 * hlf + 0] + p[1] * wf[8 * hlf + 1] + p[2] * wf[8 * hlf + 2] + p[3] * wf[8 * hlf + 3] + q[0] * wf[8 * hlf + 4] + q[1] * wf[8 * hlf + 5] + q[2] * wf[8 * hlf + 6] + q[3] * wf[8 * hlf + 7]; }
                s = wave_sum(s); if (lane == b) myv = s; }
            if (lane < 8) BIAS2[(size_t)lane * 4096 + n] = myv;
        }
    }
    }
    if (slot == 0) {
#ifndef SKIP_P5b
    {
        PHASE_PTRS();
        attn_body::AttnUnit u;
        for (int au = ahalf; AS.next(au, u); ++au) attn_body::attn_unit<8>(u.b, u.h, u.qb, (const attn_body::bf16*)AQ, (const attn_body::bf16*)KB, (const attn_body::bf16*)VB, (attn_body::bf16*)MIX, (char*)lds_raw);
    }
#endif
    }
    }
    }
    GRID_SYNC();

    for (int rep_ = 0; rep_ < REP_P6; ++rep_) {
#ifndef SKIP_P6
    {
        PHASE_PTRS();
        pg8::Gemm g{MIX, Wout_t, MLAT, DMODEL, DMODEL}; pg8::StaticOrder S; S.init(MLAT, DMODEL, G, bx);
        pg8::EpiOut E{x, D1, A2, MOD, n2g, rep_ == 0 ? rowss : (float*)(ws + WS_PROBE)};
        pg8::gemm_phase<pg8::EpiOut, pg8::StaticOrder, PG8_ALIGN, PG8_SP2>(lds, g, S, E);
    }
#endif
    }
    GRID_SYNC();

    for (int rep_ = 0; rep_ < REP_P7; ++rep_) {
#ifndef SKIP_P7
    {
        PHASE_PTRS();
        pg8::Gemm g{A2, W1_t, MLAT, DFF, DMODEL}; pg8::StaticOrder S; S.init(MLAT, DFF, G, bx);
        pg8::EpiFF1 E{HB, BIAS2, rowss};
        pg8::gemm_phase<pg8::EpiFF1, pg8::StaticOrder, PG8_ALIGN, PG8_SP2>(lds, g, S, E);
    }
#endif
    }
    GRID_SYNC();

    for (int rep_ = 0; rep_ < REP_P8; ++rep_) {
#ifndef SKIP_P8
    {
        PHASE_PTRS();
        pg8::Gemm g{HB, W2_t, MLAT, DMODEL, DFF}; pg8::StaticOrder S; S.init(MLAT, DMODEL, G, bx);
        pg8::EpiFF2N E{D1, out, MOD, fng, rep_ == 0 ? rowss2 : (float*)(ws + WS_PROBE) + MLAT, rep_ == 0 ? cnt2 : (unsigned*)(ws + WS_PROBE) + 2 * MLAT};
        pg8::gemm_phase<pg8::EpiFF2N, pg8::StaticOrder, PG8_ALIGN, PG8_SP2>(lds, g, S, E);
    }
#endif
    if (rep_ + 1 < REP_P8) GRID_SYNC(); }
}

extern "C" void kernel_launch(void* const* d_in, const int* in_sizes, int n_in, void* d_out, int out_size, void* d_ws, size_t ws_size, hipStream_t stream) {
    static int grid = 0;
    if (grid == 0) {
        if (n_in != 17 || out_size != MLAT * DMODEL || ws_size < WS_END) { fprintf(stderr, "kernel_launch: unexpected shapes (n_in %d, out %d, ws %zu); nothing launched\n", n_in, out_size, ws_size); grid = -1; return; }
        int dev = 0, cus = 0, per_cu = 0;
        if (hipGetDevice(&dev) != hipSuccess || hipDeviceGetAttribute(&cus, hipDeviceAttributeMultiprocessorCount, dev) != hipSuccess) { grid = -1; return; }
        if (hipFuncSetAttribute((const void*)fwd_megakernel, hipFuncAttributeMaxDynamicSharedMemorySize, LDS_BYTES) != hipSuccess) { fprintf(stderr, "kernel_launch: hipFuncSetAttribute failed\n"); grid = -1; return; }
        if (hipOccupancyMaxActiveBlocksPerMultiprocessor(&per_cu, (const void*)fwd_megakernel, NWAVES * 64, LDS_BYTES) != hipSuccess || per_cu < 1) { fprintf(stderr, "kernel_launch: occupancy query gave %d\n", per_cu); per_cu = 1; }
        (void)hipGetLastError();
        grid = cus - cus % 32;
        if (grid < 32) grid = cus;
    }
    if (grid < 0) return;
    if (hipMemsetAsync((char*)d_ws + WS_BAR, 0, ZERO_BYTES, stream) != hipSuccess) { fprintf(stderr, "kernel_launch: hipMemsetAsync failed\n"); return; }
    Args a{};
    for (int i = 0; i < 17; ++i) a.in[i] = (const float*)d_in[i];
    a.out = (float*)d_out; a.ws = (unsigned char*)d_ws;
    void* kargs[] = {&a};
    const hipError_t le = hipLaunchCooperativeKernel((const void*)fwd_megakernel, dim3(grid), dim3(NWAVES * 64), kargs, LDS_BYTES, stream);
    if (le != hipSuccess) fprintf(stderr, "kernel_launch: cooperative launch failed: %s (grid %d)\n", hipGetErrorName(le), grid);
}
```

```cpp
#include <hip/hip_runtime.h>
#include <cstdio>
#include <cstdint>
namespace pg8 {
#define PG8_LAS __attribute__((address_space(3)))
typedef unsigned short bf16_t;
typedef short bf16x8 __attribute__((ext_vector_type(8)));
typedef float f32x4 __attribute__((ext_vector_type(4)));
typedef unsigned u32x4 __attribute__((ext_vector_type(4)));
constexpr int BM = 256, BK = 64, HALF = 128, HTB = HALF * BK * 2  , STAGE_BYTES = 8 * HTB, NXCD = 8, WGM = 8;

__host__ __device__ __forceinline__ int lds_byte(int r, int c) { const int st = (r >> 4) * 2 + (c >> 5), rr = r & 15, cc = c & 31, ob = rr * 64 + cc * 2; return st * 1024 + (ob ^ (((ob >> 9) & 1) << 5)); }
__host__ __device__ __forceinline__ void stage_rc(int b, int& R, int& C) { const int st = b / 1024, sb = b % 1024, swz = sb ^ (((sb >> 9) & 1) << 5); R = (st >> 1) * 16 + swz / 64; C = (st & 1) * 32 + (swz % 64) / 2; }
__host__ __device__ __forceinline__ int perm32(int rho) { const int n = rho >> 4, i = rho & 15; return 8 * (i >> 2) + 4 * n + (i & 3); }

struct Unit { int pm, pn; };
struct Gemm { const bf16_t* A; const bf16_t* Bt; int M, N, K; };

struct StaticOrder {
    int nM, nN, nwg, G, c;
    __host__ __device__ void init(int M, int N, int G_, int c_) { nM = M / BM; nN = N / BM; nwg = nM * nN; G = G_; c = c_; }
    __host__ __device__ bool next(int i, Unit& u) const {
        const long L = (long)i * G + c; if (L >= nwg) return false;
        int wgid = (int)L; { const int q = nwg / NXCD, r = nwg % NXCD, xcd = wgid % NXCD, off = wgid / NXCD; wgid = (xcd < r ? xcd * (q + 1) : r * (q + 1) + (xcd - r) * q) + off; }
        const int nig = WGM * nN, gid = wgid / nig, fm = gid * WGM, gsz = (nM - fm) < WGM ? (nM - fm) : WGM;
        u.pm = fm + ((wgid % nig) % gsz); u.pn = (wgid % nig) / gsz; return true;
    }
    __device__ __forceinline__ void a_ready(const Unit&) const {}
    __device__ __forceinline__ void done(const Unit&) const {}
};

__device__ __forceinline__ unsigned cvt_pk_bf16(float lo, float hi) { unsigned r; asm volatile("v_cvt_pk_bf16_f32 %0, %1, %2" : "=v"(r) : "v"(lo), "v"(hi)); return r; }
typedef float f32x2 __attribute__((ext_vector_type(2)));
__device__ __forceinline__ f32x2 gelu_pk(f32x2 v) {
    const f32x2 av = __builtin_elementwise_abs(v), d = av * 0.2316418882f + 1.0f;
    f32x2 t; t.x = __builtin_amdgcn_rcpf(d.x); t.y = __builtin_amdgcn_rcpf(d.y);
    f32x2 q = t * 0.5307027145f + (-0.7265760135f); q = q * t + 0.7107068705f; q = q * t + (-0.142248368f); q = q * t + 0.127414796f; q = q * t;
    const f32x2 s = (v * v) * (-0.72134752044f);
    f32x2 e; e.x = __builtin_amdgcn_exp2f(s.x); e.y = __builtin_amdgcn_exp2f(s.y);
    const f32x2 m = v * (q * e), r = v - m;
    f32x2 o; o.x = v.x < 0.f ? m.x : r.x; o.y = v.y < 0.f ? m.y : r.y; return o;
}

template <int ACT  > struct EpiBf16 {
    static constexpr bool PERM = true, AFTER_DRAIN = false; static_assert(ACT == 0 || ACT == 1, "EpiBf16: ACT is 0 (none) or 1 (gelu_pk)");
    bf16_t* O; int ldc; const float* bias; int split_cols; size_t split_stride; float scale0;
    __device__ __forceinline__ void operator()(const f32x4 (&acc)[2][2][4][2], const Unit& u, int wr, int wc, int fr, int fq) const {
        const int row0 = u.pm * BM + wr * 64 + fr; int colt = u.pn * BM; bf16_t* base = O;
        float sc = 1.f; if (split_cols) { const int t = colt / split_cols; base += (size_t)t * split_stride; colt -= t * split_cols; if (t == 0) sc = scale0; }
        const int col0 = colt + wc * 32 + 8 * fq, bcol0 = u.pn * BM + wc * 32 + 8 * fq;
        f32x4 bv[2][2];
#pragma unroll
        for (int bj = 0; bj < 2; ++bj)
#pragma unroll
            for (int n = 0; n < 2; ++n) bv[bj][n] = bias ? *(const f32x4*)(bias + bcol0 + bj * HALF + 4 * n) : (f32x4){0.f, 0.f, 0.f, 0.f};
#pragma unroll
        for (int ai = 0; ai < 2; ++ai)
#pragma unroll
            for (int m = 0; m < 4; ++m) { bf16_t* rowp = base + (size_t)(row0 + ai * HALF + m * 16) * ldc + col0;
#pragma unroll
                for (int bj = 0; bj < 2; ++bj) { f32x4 v0 = acc[ai][bj][m][0] + bv[bj][0], v1 = acc[ai][bj][m][1] + bv[bj][1];
                    if (ACT == 1) { f32x2 a = gelu_pk((f32x2){v0[0], v0[1]}), b = gelu_pk((f32x2){v0[2], v0[3]}), c = gelu_pk((f32x2){v1[0], v1[1]}), d = gelu_pk((f32x2){v1[2], v1[3]});
                        v0 = (f32x4){a.x, a.y, b.x, b.y}; v1 = (f32x4){c.x, c.y, d.x, d.y}; }
                    v0 = v0 * sc; v1 = v1 * sc; u32x4 w; w.x = cvt_pk_bf16(v0[0], v0[1]); w.y = cvt_pk_bf16(v0[2], v0[3]); w.z = cvt_pk_bf16(v1[0], v1[1]); w.w = cvt_pk_bf16(v1[2], v1[3]);
                    *(u32x4*)(rowp + bj * HALF) = w; } }
    }
};
__device__ __forceinline__ void sincos_rad(float x, float& s, float& c) {
    const float n = __builtin_rintf(x * 0.15915493667125702f);
    float fr = __builtin_fmaf(x, 0.15915493667125702f, -n);
    fr = __builtin_fmaf(x, 6.420638326565253e-09f, fr);
    s = __builtin_amdgcn_sinf(fr); c = __builtin_amdgcn_cosf(fr);
}
__device__ __forceinline__ u32x4 pack8(const f32x4 a, const f32x4 b) { u32x4 w; w.x = cvt_pk_bf16(a[0], a[1]); w.y = cvt_pk_bf16(a[2], a[3]); w.z = cvt_pk_bf16(b[0], b[1]); w.w = cvt_pk_bf16(b[2], b[3]); return w; }

struct EpiIn {
    static constexpr bool PERM = true, AFTER_DRAIN = false;
    bf16_t *RQ, *RK, *RV, *RG, *AQ, *KB, *VB; const float *qg, *kg;
    __device__ __forceinline__ void operator()(const f32x4 (&acc)[2][2][4][2], const Unit& u, int wr, int wc, int fr_, int fq_) const {
        int fr = fr_, fq = fq_; asm volatile("" : "+v"(fr), "+v"(fq));
        const int pn = u.pn; const bool ctx = u.pm >= 128;
        if (ctx && (pn < 2 || (pn >= 6 && pn < 10))) return;
        const int rowt = u.pm * BM + wr * 64 + fr;
        if (pn < 4) {
            const int head = 2 * (pn & 1) + (wc >> 1), dbase = 32 * (wc & 1) + 8 * fq; const bool isk = pn >= 2;
            bf16_t* dst = isk ? RK : RQ; const float sc = isk ? 0.08838834764831845f : 1.0f;
            float fqv[8];
#pragma unroll
            for (int i = 0; i < 8; ++i) fqv[i] = __builtin_amdgcn_exp2f(-(float)(dbase + i) * 0.20762050593046014f);
#pragma unroll
            for (int ai = 0; ai < 2; ++ai)
#pragma unroll
                for (int m = 0; m < 4; ++m) { const int row = rowt + ai * HALF + m * 16; const float t = (float)(row & 4095);
                    f32x4 o1[2], o2[2];
#pragma unroll
                    for (int n = 0; n < 2; ++n)
#pragma unroll
                        for (int j = 0; j < 4; ++j) { const float x1 = acc[ai][0][m][n][j], x2 = acc[ai][1][m][n][j]; float s = 0.f, c = 1.f;
                            if (!ctx) sincos_rad(t * fqv[4 * n + j], s, c);
                            o1[n][j] = (x1 * c - x2 * s) * sc; o2[n][j] = (x1 * s + x2 * c) * sc; }
                    bf16_t* p = dst + (size_t)row * 512 + head * 128 + dbase;
                    *(u32x4*)p = pack8(o1[0], o1[1]); *(u32x4*)(p + 64) = pack8(o2[0], o2[1]);  asm volatile("" ::: "memory"); }
        } else if (pn < 8) {
            const bool isg = pn >= 6; bf16_t* dst = isg ? RG : RV; const int col0 = (pn & 1) * 256 + wc * 32 + 8 * fq;
#pragma unroll
            for (int ai = 0; ai < 2; ++ai)
#pragma unroll
                for (int m = 0; m < 4; ++m) { const int row = rowt + ai * HALF + m * 16;
#pragma unroll
                    for (int bj = 0; bj < 2; ++bj) { f32x4 a = acc[ai][bj][m][0], b = acc[ai][bj][m][1];
                        if (isg) {
#pragma unroll
                            for (int j = 0; j < 4; ++j) { a[j] = a[j] * __builtin_amdgcn_rcpf(1.0f + __builtin_amdgcn_exp2f(-a[j] * 1.4426950408889634f)); b[j] = b[j] * __builtin_amdgcn_rcpf(1.0f + __builtin_amdgcn_exp2f(-b[j] * 1.4426950408889634f)); } }
                        *(u32x4*)(dst + (size_t)row * 512 + col0 + bj * HALF) = pack8(a, b); } }
        } else {
            const bool isq = pn < 10, isv = !isq && wc >= 2; const int d0 = 8 * fq;
            if (isv) {
#pragma unroll
                for (int ai = 0; ai < 2; ++ai)
#pragma unroll
                    for (int m = 0; m < 4; ++m) { const int row = rowt + ai * HALF + m * 16;
                        const int bb = ctx ? ((row - 32768) >> 8) : (row >> 12), ps = ctx ? ((row - 32768) & 255) : (256 + (row & 4095));
                        bf16_t* p = VB + ((size_t)((bb * 2 + (wc - 2)) * 68 + (ps >> 6))) * 4096 + ((ps & 63) >> 4) * 512 + ((ps & 15) * 4 + fq) * 8;
                        *(u32x4*)p = pack8(acc[ai][0][m][0], acc[ai][0][m][1]); *(u32x4*)(p + 4 * 512) = pack8(acc[ai][1][m][0], acc[ai][1][m][1]); }
            } else {
                const float* g = isq ? qg : kg; const float osc = isq ? 0.18033688011112042f : 1.0f;
                const f32x4 g1a = *(const f32x4*)(g + d0), g1b = *(const f32x4*)(g + d0 + 4), g2a = *(const f32x4*)(g + 32 + d0), g2b = *(const f32x4*)(g + 32 + d0 + 4);
                float afv[8];
#pragma unroll
                for (int i = 0; i < 8; ++i) afv[i] = __builtin_amdgcn_exp2f(-(float)(8 * (fq & 1) + i) * 0.8304820237218405f);
#pragma unroll
                for (int ai = 0; ai < 2; ++ai)
#pragma unroll
                    for (int m = 0; m < 4; ++m) { const int row = rowt + ai * HALF + m * 16; const int t = row & 4095;
                        const float pv = (float)((fq < 2) ? (t >> 6) : (t & 63));
                        float ss = 0.f;
#pragma unroll
                        for (int bj = 0; bj < 2; ++bj)
#pragma unroll
                            for (int n = 0; n < 2; ++n) { const f32x4 x = acc[ai][bj][m][n]; ss += (x[0] * x[0] + x[1] * x[1]) + (x[2] * x[2] + x[3] * x[3]); }
                        ss += __shfl_xor(ss, 16); ss += __shfl_xor(ss, 32);
                        const float rstd = __builtin_amdgcn_rsqf(ss * (1.0f / 64.0f) + 1e-6f);
                        f32x4 o1[2], o2[2];
#pragma unroll
                        for (int n = 0; n < 2; ++n)
#pragma unroll
                            for (int j = 0; j < 4; ++j) { const float y1 = acc[ai][0][m][n][j] * rstd * (n ? g1b[j] : g1a[j]), y2 = acc[ai][1][m][n][j] * rstd * (n ? g2b[j] : g2a[j]); float s = 0.f, c = 1.f;
                                if (!ctx) sincos_rad(pv * afv[4 * n + j], s, c);
                                o1[n][j] = (y1 * c - y2 * s) * osc; o2[n][j] = (y1 * s + y2 * c) * osc; }
                        bf16_t* p;
                        if (isq) p = AQ + (size_t)row * 512 + (4 * (pn - 8) + wc) * 64 + d0;
                        int h2 = 32;
                        if (!isq) { const int bb = ctx ? ((row - 32768) >> 8) : (row >> 12), ps = ctx ? ((row - 32768) & 255) : (256 + t);
                            p = KB + ((size_t)((bb * 2 + wc) * 68 + (ps >> 6))) * 4096 + fq * 512 + (ps & 63) * 8; h2 = 4 * 512; }
                        *(u32x4*)p = pack8(o1[0], o1[1]); *(u32x4*)(p + h2) = pack8(o2[0], o2[1]);  asm volatile("" ::: "memory"); }
            }
        }
    }
};

__device__ __forceinline__ float bflo(unsigned u) { return __builtin_bit_cast(float, u << 16); }
__device__ __forceinline__ float bfhi(unsigned u) { return __builtin_bit_cast(float, u & 0xffff0000u); }
struct EpiOut {
    static constexpr bool PERM = true, AFTER_DRAIN = false;
    const float* x; bf16_t* X1B; bf16_t* A2; const float* mod; const float* n2g; float* rowss;
    __device__ __forceinline__ void operator()(const f32x4 (&acc)[2][2][4][2], const Unit& u, int wr, int wc, int fr, int fq) const {
        const int b = u.pm >> 4; const float* mb = mod + (size_t)b * 6144; const int colb = u.pn * BM + wc * 32 + 8 * fq;
        f32x4 g1v[2][2], csv[2][2];
#pragma unroll
        for (int bj = 0; bj < 2; ++bj)
#pragma unroll
            for (int n = 0; n < 2; ++n) { const int c = colb + bj * HALF + 4 * n; g1v[bj][n] = *(const f32x4*)(mb + 2048 + c);
                const f32x4 s2 = *(const f32x4*)(mb + 4096 + c), gn = *(const f32x4*)(n2g + c); csv[bj][n] = gn * (s2 + 1.0f); }
#pragma unroll
        for (int aim = 0; aim < 4; ++aim) { const int ai = aim >> 1, m0 = (aim & 1) * 2;
            f32x4 xv[2][2][2];
#pragma unroll
            for (int mm = 0; mm < 2; ++mm)
#pragma unroll
                for (int bj = 0; bj < 2; ++bj) { const size_t off = (size_t)(u.pm * BM + ai * HALF + wr * 64 + (m0 + mm) * 16 + fr) * 1024 + colb + bj * HALF; xv[mm][bj][0] = *(const f32x4*)(x + off); xv[mm][bj][1] = *(const f32x4*)(x + off + 4); }
#pragma unroll
            for (int mm = 0; mm < 2; ++mm) asm volatile("" : "+v"(xv[mm][0][0]), "+v"(xv[mm][0][1]), "+v"(xv[mm][1][0]), "+v"(xv[mm][1][1]));
#pragma unroll
            for (int mm = 0; mm < 2; ++mm) { const int m = m0 + mm; const int row = u.pm * BM + ai * HALF + wr * 64 + m * 16 + fr; float ss = 0.f;
#pragma unroll
                for (int bj = 0; bj < 2; ++bj) { const size_t off = (size_t)row * 1024 + colb + bj * HALF;
                    const u32x4 xw = pack8(xv[mm][bj][0] + g1v[bj][0] * acc[ai][bj][m][0], xv[mm][bj][1] + g1v[bj][1] * acc[ai][bj][m][1]);
                    *(u32x4*)(X1B + off) = xw;
                    const f32x4 ya = (f32x4){bflo(xw.x), bfhi(xw.x), bflo(xw.y), bfhi(xw.y)}, yb = (f32x4){bflo(xw.z), bfhi(xw.z), bflo(xw.w), bfhi(xw.w)};
                    ss += (ya[0] * ya[0] + ya[1] * ya[1]) + (ya[2] * ya[2] + ya[3] * ya[3]) + (yb[0] * yb[0] + yb[1] * yb[1]) + (yb[2] * yb[2] + yb[3] * yb[3]);
                    *(u32x4*)(A2 + off) = pack8(ya * csv[bj][0], yb * csv[bj][1]); }
                ss += __shfl_xor(ss, 16); ss += __shfl_xor(ss, 32);
                if (fq == 0) atomicAdd(rowss + row, ss); }
        }
    }
};

struct EpiFF1 {
    static constexpr bool PERM = true, AFTER_DRAIN = false;
    bf16_t* HB; const float* bias2; const float* rowss;
    __device__ __forceinline__ void operator()(const f32x4 (&acc)[2][2][4][2], const Unit& u, int wr, int wc, int fr, int fq) const {
        const int b = u.pm >> 4; const int colb = u.pn * BM + wc * 32 + 8 * fq;
        f32x4 bv[2][2];
#pragma unroll
        for (int bj = 0; bj < 2; ++bj)
#pragma unroll
            for (int n = 0; n < 2; ++n) bv[bj][n] = *(const f32x4*)(bias2 + (size_t)b * 4096 + colb + bj * HALF + 4 * n);
        float rsv[2][4];
#pragma unroll
        for (int ai = 0; ai < 2; ++ai)
#pragma unroll
            for (int m = 0; m < 4; ++m) rsv[ai][m] = rowss[u.pm * BM + ai * HALF + wr * 64 + m * 16 + fr];
#pragma unroll
        for (int ai = 0; ai < 2; ++ai)
#pragma unroll
            for (int m = 0; m < 4; ++m) { const int row = u.pm * BM + ai * HALF + wr * 64 + m * 16 + fr;
                const float rstd = __builtin_amdgcn_rsqf(rsv[ai][m] * (1.0f / 1024.0f) + 1e-6f);
#pragma unroll
                for (int bj = 0; bj < 2; ++bj) { f32x4 a = acc[ai][bj][m][0] * rstd + bv[bj][0], c = acc[ai][bj][m][1] * rstd + bv[bj][1];
#pragma unroll
                    for (int j = 0; j < 4; ++j) { const float ra = __builtin_fmaxf(a[j], 0.f), rc = __builtin_fmaxf(c[j], 0.f); a[j] = ra * ra; c[j] = rc * rc; }
                    *(u32x4*)(HB + (size_t)row * 4096 + colb + bj * HALF) = pack8(a, c); } }
    }
};

struct EpiFF2N {
    static constexpr bool PERM = true, AFTER_DRAIN = false;
    const bf16_t* X1B; float* out; const float* mod; const float* fng; float* rowss2; unsigned* cnt;
    __device__ __forceinline__ void operator()(f32x4 (&acc)[2][2][4][2], const Unit& u, int wr, int wc, int fr, int fq) const {
        const int b = u.pm >> 4; const float* mb = mod + (size_t)b * 6144 + 5120; const int colb = u.pn * BM + wc * 32 + 8 * fq;
        {
            f32x4 gv[2][2];
#pragma unroll
            for (int bj = 0; bj < 2; ++bj)
#pragma unroll
                for (int n = 0; n < 2; ++n) gv[bj][n] = *(const f32x4*)(mb + colb + bj * HALF + 4 * n);
#pragma unroll
            for (int ai = 0; ai < 2; ++ai) {
                u32x4 xw[4][2];
#pragma unroll
                for (int m = 0; m < 4; ++m)
#pragma unroll
                    for (int bj = 0; bj < 2; ++bj) xw[m][bj] = *(const u32x4*)(X1B + (size_t)(u.pm * BM + ai * HALF + wr * 64 + m * 16 + fr) * 1024 + colb + bj * HALF);
#pragma unroll
                for (int m = 0; m < 4; ++m) asm volatile("" : "+v"(xw[m][0]), "+v"(xw[m][1]));
#pragma unroll
                for (int m = 0; m < 4; ++m) { const int row = u.pm * BM + ai * HALF + wr * 64 + m * 16 + fr; float ss = 0.f;
#pragma unroll
                    for (int bj = 0; bj < 2; ++bj) { const u32x4 dw = xw[m][bj];
                        const f32x4 ya = (f32x4){bflo(dw.x), bfhi(dw.x), bflo(dw.y), bfhi(dw.y)} + gv[bj][0] * acc[ai][bj][m][0], yb = (f32x4){bflo(dw.z), bfhi(dw.z), bflo(dw.w), bfhi(dw.w)} + gv[bj][1] * acc[ai][bj][m][1];
                        acc[ai][bj][m][0] = ya; acc[ai][bj][m][1] = yb;
                        ss += (ya[0] * ya[0] + ya[1] * ya[1]) + (ya[2] * ya[2] + ya[3] * ya[3]) + (yb[0] * yb[0] + yb[1] * yb[1]) + (yb[2] * yb[2] + yb[3] * yb[3]); }
                    ss += __shfl_xor(ss, 16); ss += __shfl_xor(ss, 32);
                    if (fq == 0) __hip_atomic_fetch_add(rowss2 + row, ss, __ATOMIC_RELAXED, __HIP_MEMORY_SCOPE_AGENT); }
            }
        }
        asm volatile("s_waitcnt vmcnt(0)" ::: "memory");
        unsigned* cw = cnt + 64 * u.pm;
        if ((fr | fq) == 0) __hip_atomic_fetch_add(cw, 1u, __ATOMIC_RELAXED, __HIP_MEMORY_SCOPE_AGENT);
        { unsigned spins = 0;
          while ((unsigned)__builtin_amdgcn_readfirstlane(__hip_atomic_load(cw, __ATOMIC_RELAXED, __HIP_MEMORY_SCOPE_AGENT)) < 32u) { __builtin_amdgcn_s_sleep(4); if (++spins > (1u << 22)) break; } }
        asm volatile("" ::: "memory");
        f32x4 fg[2][2];
#pragma unroll
        for (int bj = 0; bj < 2; ++bj)
#pragma unroll
            for (int n = 0; n < 2; ++n) fg[bj][n] = *(const f32x4*)(fng + colb + bj * HALF + 4 * n);
        float totv[2][4];
#pragma unroll
        for (int ai = 0; ai < 2; ++ai)
#pragma unroll
            for (int m = 0; m < 4; ++m) totv[ai][m] = __hip_atomic_load(rowss2 + u.pm * BM + ai * HALF + wr * 64 + m * 16 + fr, __ATOMIC_RELAXED, __HIP_MEMORY_SCOPE_AGENT);
#pragma unroll
        for (int ai = 0; ai < 2; ++ai)
#pragma unroll
            for (int m = 0; m < 4; ++m) { const int row = u.pm * BM + ai * HALF + wr * 64 + m * 16 + fr;
                const float tot = totv[ai][m];
                const float rstd = 1.0f / __builtin_sqrtf(tot * (1.0f / 1024.0f) + 1e-6f);
#pragma unroll
                for (int bj = 0; bj < 2; ++bj) { const size_t off = (size_t)row * 1024 + colb + bj * HALF;
                    *(f32x4*)(out + off) = (acc[ai][bj][m][0] * rstd) * fg[bj][0]; *(f32x4*)(out + off + 4) = (acc[ai][bj][m][1] * rstd) * fg[bj][1]; }
                if (m & 1) asm volatile("" ::: "memory"); }
    }
};

template <class Epi, class Sched, bool ALIGN_EPI = false, bool SP2 = false>
__device__ __forceinline__ void gemm_phase(PG8_LAS unsigned char* lds, const Gemm g, const Sched& S, const Epi& E) {
    int tid_ = threadIdx.x; asm volatile("" : "+v"(tid_));
    const int tid = tid_, wid = __builtin_amdgcn_readfirstlane(tid >> 6), lane = tid & 63, wr = wid >> 2, wc = wid & 3, fr = lane & 15, fq = lane >> 4;
    const int K = g.K, nt = K / BK;
    unsigned voffA[2], voffB[2];
#pragma unroll
    for (int i = 0; i < 2; ++i) { int R, C; stage_rc(tid * 16 + i * 8192, R, C); const int Rb = Epi::PERM ? ((R & ~31) + perm32(R & 31)) : R;
        voffA[i] = (unsigned)(R * K + C) * 2u; voffB[i] = (unsigned)(Rb * K + C) * 2u; }
    const size_t kstep = (size_t)(BK * 2);
    const size_t hstep = (size_t)HALF * K * 2;
    const size_t tstep = 2 * hstep;
    const unsigned ldsw = (unsigned)wid * 1024u;
    const int aoff = lds_byte(wr * 64 + fr, fq * 8), boff = lds_byte(wc * 32 + fr, fq * 8);
#define PG8_SA(b, h) (((b) * 2 + (h)) * HTB)
#define PG8_SB(b, h) ((4 + (b) * 2 + (h)) * HTB)
#define PG8_STAGE(bufoff, gbase, voff) do { _Pragma("unroll") for (int _i = 0; _i < 2; ++_i) \
        __builtin_amdgcn_global_load_lds((const unsigned*)((const char*)(gbase) + (voff)[_i]), (PG8_LAS unsigned*)(lds + (bufoff) + ldsw + _i * 8192), 16, 0, 0); } while (0)
#define PG8_LDA(dst, b, h) do { _Pragma("unroll") for (int m = 0; m < 4; ++m) _Pragma("unroll") for (int k = 0; k < 2; ++k) dst[m][k] = *(const PG8_LAS bf16x8*)(lds + PG8_SA(b, h) + aoff + m * 2048 + k * 1024); } while (0)
#define PG8_LDB(dst, b, h) do { _Pragma("unroll") for (int n = 0; n < 2; ++n) _Pragma("unroll") for (int k = 0; k < 2; ++k) dst[n][k] = *(const PG8_LAS bf16x8*)(lds + PG8_SB(b, h) + boff + n * 2048 + k * 1024); } while (0)
#define PG8_MMA(ai, bj, At, Bt) do { __builtin_amdgcn_s_setprio(1); _Pragma("unroll") for (int m = 0; m < 4; ++m) _Pragma("unroll") for (int n = 0; n < 2; ++n) _Pragma("unroll") for (int k = 0; k < 2; ++k) \
        acc[ai][bj][m][n] = __builtin_amdgcn_mfma_f32_16x16x32_bf16(Bt[n][k], At[m][k], acc[ai][bj][m][n], 0, 0, 0); __builtin_amdgcn_s_setprio(0); } while (0)
#define PG8_WAIT_V(n) asm volatile("s_waitcnt vmcnt(" #n ")" ::: "memory")
#define PG8_WAIT_L(n) asm volatile("s_waitcnt lgkmcnt(" #n ")" ::: "memory")
#define PG8_BAR __builtin_amdgcn_s_barrier()
#define PG8_SCHED __builtin_amdgcn_sched_barrier(0)
    Unit cur, nxt; int ui = 0;
    if (!S.next(0, cur)) return;
    f32x4 acc[2][2][4][2];
#pragma unroll
    for (int a = 0; a < 2; ++a)
#pragma unroll
        for (int b = 0; b < 2; ++b)
#pragma unroll
            for (int m = 0; m < 4; ++m)
#pragma unroll
                for (int n = 0; n < 2; ++n) acc[a][b][m][n] = (f32x4){0.f, 0.f, 0.f, 0.f};
    bf16x8 At[4][2], B0[2][2], B1[2][2];
    const char* cA = (const char*)g.A + (size_t)cur.pm * tstep; const char* cB = (const char*)g.Bt + (size_t)cur.pn * tstep;
    S.a_ready(cur);
    if constexpr (SP2) {
        PG8_STAGE(PG8_SB(0, 0), cB, voffB); PG8_STAGE(PG8_SB(0, 1), cB + hstep, voffB); PG8_STAGE(PG8_SA(0, 0), cA, voffA); PG8_STAGE(PG8_SA(0, 1), cA + hstep, voffA);
        if (wr == 1) PG8_BAR;
        PG8_WAIT_V(2); PG8_BAR;
        PG8_STAGE(PG8_SB(1, 0), cB + kstep, voffB); PG8_STAGE(PG8_SA(1, 0), cA + kstep, voffA); PG8_STAGE(PG8_SB(1, 1), cB + hstep + kstep, voffB);
        PG8_WAIT_V(6); PG8_BAR;
    } else {
        PG8_STAGE(PG8_SB(0, 0), cB, voffB); PG8_STAGE(PG8_SA(0, 0), cA, voffA); PG8_STAGE(PG8_SB(0, 1), cB + hstep, voffB); PG8_STAGE(PG8_SA(0, 1), cA + hstep, voffA);
        if (wr == 1) PG8_BAR;
        PG8_WAIT_V(4); PG8_BAR;
        PG8_STAGE(PG8_SB(1, 0), cB + kstep, voffB); PG8_STAGE(PG8_SA(1, 0), cA + kstep, voffA); PG8_STAGE(PG8_SB(1, 1), cB + hstep + kstep, voffB);
        PG8_WAIT_V(6); PG8_BAR;
    }
    for (;;) {
        const bool has_next = S.next(ui + 1, nxt);
        const char* nA = has_next ? (const char*)g.A + (size_t)nxt.pm * tstep : cA; const char* nB = has_next ? (const char*)g.Bt + (size_t)nxt.pn * tstep : cB;
        for (int t = 0; t < nt; t += 2) {
            const bool last = (t == nt - 2);
            const char* a1 = cA + (size_t)(t + 1) * kstep;
            const char* a2 = last ? nA : cA + (size_t)(t + 2) * kstep; const char* b2 = last ? nB : cB + (size_t)(t + 2) * kstep;
            const char* a3 = a2 + kstep; const char* b3 = b2 + kstep;
            if (last && has_next) S.a_ready(nxt);
            if constexpr (SP2) {
            PG8_LDB(B0, 0, 0); PG8_LDB(B1, 0, 1); PG8_SCHED; PG8_LDA(At, 0, 0); PG8_STAGE(PG8_SA(1, 1), a1 + hstep, voffA);
            PG8_WAIT_V(8); PG8_WAIT_L(0); PG8_BAR; PG8_MMA(0, 0, At, B0); PG8_MMA(0, 1, At, B1); PG8_BAR; PG8_SCHED;
            PG8_LDA(At, 0, 1); PG8_STAGE(PG8_SB(0, 0), b2, voffB); PG8_STAGE(PG8_SB(0, 1), b2 + hstep, voffB); PG8_STAGE(PG8_SA(0, 0), a2, voffA);
            PG8_WAIT_V(8); PG8_WAIT_L(0); PG8_BAR; PG8_MMA(1, 0, At, B0); PG8_MMA(1, 1, At, B1); PG8_BAR; PG8_SCHED;
            PG8_LDB(B0, 1, 0); PG8_LDB(B1, 1, 1); PG8_SCHED; PG8_LDA(At, 1, 0); PG8_STAGE(PG8_SA(0, 1), a2 + hstep, voffA);
            PG8_WAIT_V(8); PG8_WAIT_L(0); PG8_BAR; PG8_MMA(0, 0, At, B0); PG8_MMA(0, 1, At, B1); PG8_BAR; PG8_SCHED;
            PG8_LDA(At, 1, 1); PG8_STAGE(PG8_SB(1, 0), b3, voffB); PG8_STAGE(PG8_SB(1, 1), b3 + hstep, voffB); PG8_STAGE(PG8_SA(1, 0), a3, voffA);
            PG8_WAIT_V(8); PG8_WAIT_L(0); PG8_BAR; PG8_MMA(1, 0, At, B0); PG8_MMA(1, 1, At, B1); PG8_BAR; PG8_SCHED;
            } else {
            PG8_LDB(B0, 0, 0); PG8_SCHED; PG8_LDA(At, 0, 0); PG8_STAGE(PG8_SA(1, 1), a1 + hstep, voffA);
            PG8_WAIT_L(8); PG8_BAR; PG8_WAIT_L(0); PG8_MMA(0, 0, At, B0); PG8_BAR; PG8_SCHED;
            PG8_LDB(B1, 0, 1); PG8_STAGE(PG8_SB(0, 0), b2, voffB);
            PG8_BAR; PG8_WAIT_L(0); PG8_MMA(0, 1, At, B1); PG8_BAR;
            PG8_LDA(At, 0, 1); PG8_STAGE(PG8_SA(0, 0), a2, voffA);
            PG8_BAR; PG8_WAIT_L(0); PG8_MMA(1, 0, At, B0); PG8_BAR; PG8_SCHED;
            PG8_STAGE(PG8_SB(0, 1), b2 + hstep, voffB);
            PG8_WAIT_V(6); PG8_BAR; PG8_MMA(1, 1, At, B1); PG8_BAR;
            PG8_LDB(B0, 1, 0); PG8_SCHED; PG8_LDA(At, 1, 0); PG8_STAGE(PG8_SA(0, 1), a2 + hstep, voffA);
            PG8_WAIT_L(8); PG8_BAR; PG8_WAIT_L(0); PG8_MMA(0, 0, At, B0); PG8_BAR; PG8_SCHED;
            PG8_LDB(B1, 1, 1); PG8_STAGE(PG8_SB(1, 0), b3, voffB);
            PG8_BAR; PG8_WAIT_L(0); PG8_MMA(0, 1, At, B1); PG8_BAR;
            PG8_LDA(At, 1, 1); PG8_STAGE(PG8_SA(1, 0), a3, voffA);
            PG8_BAR; PG8_WAIT_L(0); PG8_MMA(1, 0, At, B0); PG8_BAR; PG8_SCHED;
            PG8_STAGE(PG8_SB(1, 1), b3 + hstep, voffB);
            PG8_WAIT_V(6); PG8_BAR; PG8_MMA(1, 1, At, B1); PG8_BAR;
            }
        }
        if constexpr (ALIGN_EPI) { if (wr == 0) PG8_BAR; }
        if constexpr (!Epi::AFTER_DRAIN) { E(acc, cur, wr, wc, fr, fq); S.done(cur); }
        if (!has_next) break;
#pragma unroll
        for (int a = 0; a < 2; ++a)
#pragma unroll
            for (int b = 0; b < 2; ++b)
#pragma unroll
                for (int m = 0; m < 4; ++m)
#pragma unroll
                    for (int n = 0; n < 2; ++n) acc[a][b][m][n] = (f32x4){0.f, 0.f, 0.f, 0.f};
        cur = nxt; cA = nA; cB = nB; ++ui;
        if constexpr (ALIGN_EPI) { if (wr == 1) PG8_BAR; }
    }
    PG8_WAIT_V(0);
    if constexpr (!ALIGN_EPI) { if (wr == 0) PG8_BAR; }
    PG8_BAR;
    if constexpr (Epi::AFTER_DRAIN) { E.fused(acc, cur, wr, wc, fr, fq, lds, wid, lane); S.done(cur); }
#undef PG8_SA
#undef PG8_SB
#undef PG8_STAGE
#undef PG8_LDA
#undef PG8_LDB
#undef PG8_MMA
#undef PG8_WAIT_V
#undef PG8_WAIT_L
#undef PG8_BAR
#undef PG8_SCHED
}
}

#ifndef PG8_SP2
#define PG8_SP2 true
#endif
#ifndef PG8_ALIGN
#define PG8_ALIGN true
#endif
#include <hip/hip_bf16.h>
#include <cmath>
namespace attn_body {
using bf16=__hip_bfloat16;
using bf16x8=__attribute__((ext_vector_type(8)))short;
using s16x4=__attribute__((ext_vector_type(4)))short;
using f32x16=__attribute__((ext_vector_type(16)))float;
using u32x4=__attribute__((ext_vector_type(4)))unsigned;
constexpr int BATCH=8,NHEAD=8,SEQ=4096,KVLEN=4352,D=64,QP=512,KP=128,OP=1024,OCOL0=512;
constexpr int NW=8,QBLK=32,QB=QBLK*NW,KVBLK=64,NQB=SEQ/QB;
constexpr int ATTN_UNIT_ROWS=QB;
__device__ __forceinline__ int crow(int r,int hi){return (r&3)+8*(r>>2)+4*hi;}
#define SBAR() __builtin_amdgcn_sched_barrier(0)
__device__ __forceinline__ void cmask(f32x16&p0,f32x16&p1,int jb,int qrel,int hi){
  const float NEG=-INFINITY; int kb=64*jb+4*hi;
  #pragma unroll
  for(int r=0;r<16;++r){int kv=kb+(r&3)+8*(r>>2); if(kv>qrel)p0[r]=NEG; if(kv+32>qrel)p1[r]=NEG;}
}

constexpr int NSLOT=3, SLOTB=8192;
constexpr int LDS_K=0, LDS_V=NSLOT*SLOTB, LDS_WS=2*NSLOT*SLOTB, LDS_OST=LDS_WS+NW*64*4, LDS_BYTES=LDS_OST+NW*4096;
constexpr float C2=0.125f*1.4426950408889634f;
__device__ __forceinline__ void glds16(const void*gsrc,unsigned lds_dst){unsigned keep;
  asm volatile("s_mov_b32 %0, m0\n\ts_mov_b32 m0, %2\n\ts_nop 0\n\tglobal_load_lds_dwordx4 %1, off\n\ts_mov_b32 m0, %0":"=&s"(keep):"v"(gsrc),"s"(lds_dst):"memory");}
__device__ __forceinline__ float max3f(float a,float b,float c){float r;asm("v_max3_f32 %0, %1, %2, %3":"=v"(r):"v"(a),"v"(b),"v"(c));return r;}
__device__ __forceinline__ float max2f(float a,float b){float r;asm("v_max_f32_e32 %0, %1, %2":"=v"(r):"v"(a),"v"(b));return r;}
__device__ __forceinline__ float fadd_s(float a,float b){float r;asm("v_add_f32_e32 %0, %1, %2":"=v"(r):"v"(a),"v"(b));return r;}
__device__ __forceinline__ float fsub_s(float a,float b){float r;asm("v_sub_f32_e32 %0, %1, %2":"=v"(r):"v"(a),"v"(b));return r;}
typedef float f32x2_t __attribute__((ext_vector_type(2))); typedef __bf16 bf16x2_t __attribute__((ext_vector_type(2)));
__device__ __forceinline__ unsigned cvtpk_s(float lo,float hi){f32x2_t v={lo,hi};bf16x2_t b=__builtin_convertvector(v,bf16x2_t);return __builtin_bit_cast(unsigned,b);}
#define WAIT_BAR(N) asm volatile("s_waitcnt vmcnt(" #N ") lgkmcnt(0)\n\ts_barrier":::"memory")

__device__ __forceinline__ void qkt(f32x16&p0,f32x16&p1,const char*Kslot,const bf16x8*qr,const f32x16&negm,int r32,int hi){
  const char*kb=Kslot+hi*1024+r32*16;
  #pragma unroll
  for(int d0=0;d0<4;++d0){
    const bf16x8 b0=*reinterpret_cast<const bf16x8*>(kb+d0*2048);
    const bf16x8 b1=*reinterpret_cast<const bf16x8*>(kb+d0*2048+512);
    if(d0==0){p0=__builtin_amdgcn_mfma_f32_32x32x16_bf16(b0,qr[0],negm,0,0,0);p1=__builtin_amdgcn_mfma_f32_32x32x16_bf16(b1,qr[0],negm,0,0,0);}
    else{p0=__builtin_amdgcn_mfma_f32_32x32x16_bf16(b0,qr[d0],p0,0,0,0);p1=__builtin_amdgcn_mfma_f32_32x32x16_bf16(b1,qr[d0],p1,0,0,0);}}
}
typedef __attribute__((address_space(3))) const char* lds_cptr;
typedef short v4i16_t __attribute__((ext_vector_type(4)));
__device__ __forceinline__ void kload8(bf16x8*kf,lds_cptr kp){
  kf[0]=*(const __attribute__((address_space(3))) bf16x8*)(kp);      kf[1]=*(const __attribute__((address_space(3))) bf16x8*)(kp+512);
  kf[2]=*(const __attribute__((address_space(3))) bf16x8*)(kp+2048); kf[3]=*(const __attribute__((address_space(3))) bf16x8*)(kp+2560);
  kf[4]=*(const __attribute__((address_space(3))) bf16x8*)(kp+4096); kf[5]=*(const __attribute__((address_space(3))) bf16x8*)(kp+4608);
  kf[6]=*(const __attribute__((address_space(3))) bf16x8*)(kp+6144); kf[7]=*(const __attribute__((address_space(3))) bf16x8*)(kp+6656);
}
__device__ __forceinline__ void kload2(bf16x8*kf,lds_cptr kp,int j){ kf[2*j]=*(const __attribute__((address_space(3))) bf16x8*)(kp+j*2048); kf[2*j+1]=*(const __attribute__((address_space(3))) bf16x8*)(kp+j*2048+512); }
__device__ __forceinline__ s16x4 vtr(lds_cptr p){ return __builtin_bit_cast(s16x4,__builtin_amdgcn_ds_read_tr16_b64_v4i16((__attribute__((address_space(3))) v4i16_t*)p)); }
__device__ __forceinline__ float rowmax(const f32x16&p0,const f32x16&p1){
  float a=max3f(p0[0],p0[1],p1[0]),b=max3f(p0[2],p0[3],p1[1]);a=max3f(a,p1[2],p1[3]);
  #pragma unroll
  for(int r=4;r<16;r+=4){a=max3f(a,p0[r],p0[r+1]);b=max3f(b,p0[r+2],p0[r+3]);a=max3f(a,p1[r],p1[r+1]);b=max3f(b,p1[r+2],p1[r+3]);}
  const float m=max2f(a,b);
  auto rr=__builtin_amdgcn_permlane32_swap(__float_as_uint(m),__float_as_uint(m),false,false);
  return max2f(__uint_as_float(rr[0]),__uint_as_float(rr[1]));
}
__device__ __forceinline__ void pv(f32x16*o,int vb,bf16x8 pa0,bf16x8 pa1,bf16x8 pa2,bf16x8 pa3){
  #pragma unroll
  for(int d0=0;d0<2;++d0){s16x4 lo[4],hi[4];
    #pragma unroll
    for(int ks=0;ks<4;++ks){
      asm volatile("ds_read_b64_tr_b16 %0,%1 offset:%c2":"=&v"(lo[ks]):"v"(vb),"i"(d0*4096+ks*1024):"memory");
      asm volatile("ds_read_b64_tr_b16 %0,%1 offset:%c2":"=&v"(hi[ks]):"v"(vb),"i"(d0*4096+ks*1024+512):"memory");}
    asm volatile("s_waitcnt lgkmcnt(0)":::"memory");SBAR();
    #define PK(k) (bf16x8){lo[k][0],lo[k][1],lo[k][2],lo[k][3],hi[k][0],hi[k][1],hi[k][2],hi[k][3]}
    o[d0]=__builtin_amdgcn_mfma_f32_32x32x16_bf16(pa0,PK(0),o[d0],0,0,0);
    o[d0]=__builtin_amdgcn_mfma_f32_32x32x16_bf16(pa1,PK(1),o[d0],0,0,0);
    o[d0]=__builtin_amdgcn_mfma_f32_32x32x16_bf16(pa2,PK(2),o[d0],0,0,0);
    o[d0]=__builtin_amdgcn_mfma_f32_32x32x16_bf16(pa3,PK(3),o[d0],0,0,0);
    #undef PK
  }
}

#ifndef ATTN_STORE16
#define ATTN_STORE16(p,v) (*(u32x4*)(p)=(v))
#endif
template<int THRL> __device__ __forceinline__ void attn_unit(int b,int h,int qb,const bf16*Q,const bf16*__restrict__ K,const bf16*__restrict__ V,bf16*O,char*shm){
  int tid_=threadIdx.x; asm volatile("":"+v"(tid_));
  const int tid=tid_,lane=tid&63,r32=lane&31,hi=lane>>5; const int wid=__builtin_amdgcn_readfirstlane(tid>>6);
  const long rowbase=(long)b*SEQ; const long kvbase=(long)b*KVLEN; const int q0=qb*QB;
  const bf16*Qw=Q+(rowbase+q0+wid*QBLK)*QP+h*D;
  const bf16*Kh=K+((long)(b*2+(h>>2))*(KVLEN/KVBLK))*4096,*Vh=V+((long)(b*2+(h>>2))*(KVLEN/KVBLK))*4096;
  const unsigned lds0=(unsigned)(uintptr_t)shm;
  float*wsf=(float*)(shm+LDS_WS)+wid*64;
  const bf16*ksrc=Kh+wid*512+lane*8;
  const bf16*vsrc=Vh+wid*512+lane*8;
  const unsigned kdst=lds0+LDS_K+wid*1024, vdst=lds0+LDS_V+wid*1024;
  #define DMA_K(t,slot) glds16(ksrc+(long)(t)*4096,(unsigned)__builtin_amdgcn_readfirstlane(kdst+(slot)))
  #define DMA_V(t,slot) glds16(vsrc+(long)(t)*4096,(unsigned)__builtin_amdgcn_readfirstlane(vdst+(slot)))
  const int vb0=(int)(lds0+LDS_V)+((lane>>4)&1)*32+(lane&3)*8+(4*hi+((lane&15)>>2))*64;
  const char*Kbase=shm+LDS_K; bf16x8 kf[8];
  const lds_cptr shm3=(lds_cptr)shm; const lds_cptr kp0=shm3+LDS_K+hi*1024+r32*16; const lds_cptr vp0=shm3+LDS_V+((lane>>4)&1)*32+(lane&3)*8+(4*hi+((lane&15)>>2))*64;
  const int NT=KVLEN/KVBLK;
  DMA_K(0,0);DMA_V(0,0);DMA_K(1,SLOTB);
  bf16x8 qr[4];
  #pragma unroll
  for(int d0=0;d0<4;++d0)qr[d0]=*reinterpret_cast<const bf16x8*>(&Qw[(long)r32*QP+d0*16+hi*8]);
  float mhat=0.f,l_reg=0.f;f32x16 o[2];o[0]=f32x16{};o[1]=f32x16{};f32x16 negm=f32x16{};asm volatile("":"+v"(negm));
    #define CMASK(P0,P1,t) do{}while(0)
  bool resc=false;
  #define START(P0,P1) do{ const float rm=rowmax(P0,P1); resc=false; \
    { const float dl=rm; mhat=fadd_s(mhat,dl); \
      _Pragma("unroll") for(int r=0;r<16;++r){P0[r]=fsub_s(P0[r],dl);P1[r]=fsub_s(P1[r],dl);} \
      _Pragma("unroll") for(int r=0;r<16;++r)negm[r]=-mhat; asm volatile("":"+v"(negm)); } \
    _Pragma("unroll") for(int r=0;r<16;++r)P0[r]=__builtin_amdgcn_exp2f(P0[r]); }while(0)
  #define RESC() do{ if(resc){ asm volatile("s_waitcnt lgkmcnt(0)":::"memory"); \
      _Pragma("unroll") for(int d_=0;d_<2;++d_) _Pragma("unroll") for(int r=0;r<16;++r)o[d_][r]*=wsf[crow(r,hi)]; } }while(0)
  f32x16 pA0,pA1,pB0,pB1;
  int sl_prev=0,sl_cur=0,sl_next=SLOTB;
  #define ROT() do{sl_prev=sl_cur;sl_cur=sl_next;sl_next=(sl_next==(NSLOT-1)*SLOTB)?0:sl_next+SLOTB;}while(0)
  DMA_K(2,2*SLOTB);
  WAIT_BAR(3);
  qkt(pA0,pA1,Kbase,qr,negm,r32,hi);asm volatile("s_nop 15\n\ts_nop 7":"+v"(pA0),"+v"(pA1));CMASK(pA0,pA1,0);
  START(pA0,pA1);
  _Pragma("unroll") for(int r=0;r<16;++r)pA1[r]=__builtin_amdgcn_exp2f(pA1[r]);
  WAIT_BAR(0);
  DMA_K(3,0);DMA_V(1,SLOTB);
  ROT();
  kload8(kf,kp0+sl_cur);
  WAIT_BAR(2);
  s16x4 vlo[8],vhi[8]; u32x4 pw0,pw1,pw2,pw3;
  #define PKW(P,B) cvtpk_s(P[B],P[B+1])
  #define PAF(k) __builtin_bit_cast(bf16x8,pw##k)
  #define VFR(i) (bf16x8){vlo[i][0],vlo[i][1],vlo[i][2],vlo[i][3],vhi[i][0],vhi[i][1],vhi[i][2],vhi[i][3]}
  #define PIN(x) asm volatile("":"+v"(x))
  #define MX3(a,b,c) __builtin_fmaxf(__builtin_fmaxf((a),(b)),(c))
  #define GAPA(MF,A0,A1,A2,A3,W0,W1,PW) do{ MF; sacc+=A0; sacc+=A1; sacc+=A2; sacc+=A3; PIN(sacc); W0; W1; PIN(PW); SBAR(); }while(0)
  #define EX(v) __builtin_amdgcn_exp2f(v)
  #define GAPB(MF,X,B) do{ MF; X[B]=EX(X[B]); X[B+1]=EX(X[B+1]); X[B+2]=EX(X[B+2]); X[B+3]=EX(X[B+3]); PIN(X); SBAR(); }while(0)
  #define VRD(i) do{ vlo[i]=vtr(vp_+(((i)>>2)*4096+((i)&3)*1024)); vhi[i]=vtr(vp_+(((i)>>2)*4096+((i)&3)*1024+512)); }while(0)
  #define KRD(G,j) do{ if(G){ kload2(kf,kp0+sl_next,j); SBAR(); } }while(0)
  #define STEP(C0,C1,P0,P1,t,GK,GV,GL) do{ SBAR(); \
    const lds_cptr vp_=vp0+sl_prev; \
    VRD(0); SBAR(); float sacc=(P0[0]+P0[1]); \
    GAPA(C0=__builtin_amdgcn_mfma_f32_32x32x16_bf16(kf[0],qr[0],negm,0,0,0), P0[2],P0[3],P0[4],P0[5],     pw0[0]=PKW(P0,0), pw0[1]=PKW(P0,2), pw0); \
    VRD(4); SBAR(); GAPA(C1=__builtin_amdgcn_mfma_f32_32x32x16_bf16(kf[1],qr[0],negm,0,0,0), P0[6],P0[7],P0[8],P0[9],     pw0[2]=PKW(P0,4), pw0[3]=PKW(P0,6), pw0); \
    VRD(1); SBAR(); GAPA(C0=__builtin_amdgcn_mfma_f32_32x32x16_bf16(kf[2],qr[1],C0,0,0,0),   P0[10],P0[11],P0[12],P0[13], pw1[0]=PKW(P0,8), pw1[1]=PKW(P0,10), pw1); \
    VRD(5); SBAR(); GAPA(C1=__builtin_amdgcn_mfma_f32_32x32x16_bf16(kf[3],qr[1],C1,0,0,0),   P0[14],P0[15],P1[0],P1[1],   pw1[2]=PKW(P0,12),pw1[3]=PKW(P0,14), pw1); \
    VRD(2); SBAR(); GAPA(C0=__builtin_amdgcn_mfma_f32_32x32x16_bf16(kf[4],qr[2],C0,0,0,0),   P1[2],P1[3],P1[4],P1[5],     pw2[0]=PKW(P1,0), pw2[1]=PKW(P1,2), pw2); \
    VRD(6); SBAR(); GAPA(C1=__builtin_amdgcn_mfma_f32_32x32x16_bf16(kf[5],qr[2],C1,0,0,0),   P1[6],P1[7],P1[8],P1[9],     pw2[2]=PKW(P1,4), pw2[3]=PKW(P1,6), pw2); \
    VRD(3); SBAR(); GAPA(C0=__builtin_amdgcn_mfma_f32_32x32x16_bf16(kf[6],qr[3],C0,0,0,0),   P1[10],P1[11],P1[12],P1[13], pw3[0]=PKW(P1,8), pw3[1]=PKW(P1,10), pw3); \
    VRD(7); SBAR(); GAPA(C1=__builtin_amdgcn_mfma_f32_32x32x16_bf16(kf[7],qr[3],C1,0,0,0),   P1[14],P1[15],0.f,0.f,       pw3[2]=PKW(P1,12),pw3[3]=PKW(P1,14), pw3); \
    l_reg+=sacc; \
    if(GK){DMA_K((t)+3,sl_cur);} if(GV){DMA_V((t)+1,sl_next);} \
    CMASK(C0,C1,t); \
    { float a=MX3(C0[0],C0[1],C1[0]),b=MX3(C0[2],C0[3],C1[1]); a=MX3(a,C1[2],C1[3]); \
      _Pragma("unroll") for(int r=4;r<16;r+=4){a=MX3(a,C0[r],C0[r+1]);b=MX3(b,C0[r+2],C0[r+3]);a=MX3(a,C1[r],C1[r+1]);b=MX3(b,C1[r+2],C1[r+3]);} \
      float rm=__builtin_fmaxf(a,b); { auto rr=__builtin_amdgcn_permlane32_swap(__float_as_uint(rm),__float_as_uint(rm),false,false); rm=__builtin_fmaxf(__uint_as_float(rr[0]),__uint_as_float(rr[1])); } \
      resc=false; \
      if(__builtin_expect(__any(rm>(float)THRL),0)){ const float dl=__builtin_fmaxf(rm,0.f); mhat+=dl; \
        _Pragma("unroll") for(int r=0;r<16;++r){C0[r]-=dl;C1[r]-=dl;} \
        _Pragma("unroll") for(int r=0;r<16;++r)negm[r]=-mhat; asm volatile("":"+v"(negm)); \
        const float f=__builtin_amdgcn_exp2f(-dl); l_reg*=f; if(hi==0)wsf[r32]=f; resc=true; } } \
    SBAR(); \
    GAPB(o[0]=__builtin_amdgcn_mfma_f32_32x32x16_bf16(PAF(0),VFR(0),o[0],0,0,0), C0,0); \
    GAPB(o[1]=__builtin_amdgcn_mfma_f32_32x32x16_bf16(PAF(0),VFR(4),o[1],0,0,0), C0,4); \
    KRD(GL,0); GAPB(o[0]=__builtin_amdgcn_mfma_f32_32x32x16_bf16(PAF(1),VFR(1),o[0],0,0,0), C0,8); \
    KRD(GL,1); GAPB(o[1]=__builtin_amdgcn_mfma_f32_32x32x16_bf16(PAF(1),VFR(5),o[1],0,0,0), C0,12); \
    KRD(GL,2); GAPB(o[0]=__builtin_amdgcn_mfma_f32_32x32x16_bf16(PAF(2),VFR(2),o[0],0,0,0), C1,0); \
    KRD(GL,3); GAPB(o[1]=__builtin_amdgcn_mfma_f32_32x32x16_bf16(PAF(2),VFR(6),o[1],0,0,0), C1,4); \
    GAPB(o[0]=__builtin_amdgcn_mfma_f32_32x32x16_bf16(PAF(3),VFR(3),o[0],0,0,0), C1,8); \
    GAPB(o[1]=__builtin_amdgcn_mfma_f32_32x32x16_bf16(PAF(3),VFR(7),o[1],0,0,0), C1,12); \
    }while(0)
  int t=1;
  #undef CMASK
  #define CMASK(P0,P1,t) do{}while(0)
  for(;t+5<NT;t+=2){
    STEP(pB0,pB1,pA0,pA1,t,true,true,true);     WAIT_BAR(2); RESC(); ROT();
    STEP(pA0,pA1,pB0,pB1,t+1,true,true,true);   WAIT_BAR(2); RESC(); ROT();
  }
  #undef CMASK
  #define CMASK(P0,P1,t) do{}while(0)
  #define ENDW(tt) do{ if((tt)+3<NT){WAIT_BAR(2);} else if((tt)+2<NT){WAIT_BAR(1);} else {WAIT_BAR(0);} }while(0)
  for(;t+1<NT;t+=2){
    STEP(pB0,pB1,pA0,pA1,t,(t+3<NT),(t+1<NT),(t+1<NT));       ENDW(t);   RESC(); ROT();
    STEP(pA0,pA1,pB0,pB1,t+1,(t+4<NT),(t+2<NT),(t+2<NT));     ENDW(t+1); RESC(); ROT();
  }
  STEP(pB0,pB1,pA0,pA1,NT-1,false,false,false); RESC();
  { float sacc=pB0[0]+pB0[1]; _Pragma("unroll") for(int r=2;r<16;++r)sacc+=pB0[r]; _Pragma("unroll") for(int r=0;r<16;++r)sacc+=pB1[r]; l_reg+=sacc;
    pw0=(u32x4){PKW(pB0,0),PKW(pB0,2),PKW(pB0,4),PKW(pB0,6)};pw1=(u32x4){PKW(pB0,8),PKW(pB0,10),PKW(pB0,12),PKW(pB0,14)};pw2=(u32x4){PKW(pB1,0),PKW(pB1,2),PKW(pB1,4),PKW(pB1,6)};pw3=(u32x4){PKW(pB1,8),PKW(pB1,10),PKW(pB1,12),PKW(pB1,14)};
    SBAR(); pv(o,vb0+sl_cur,PAF(0),PAF(1),PAF(2),PAF(3)); }
  #undef PKW
  #undef PAF
  #undef VFR
  #undef PIN
  #undef MX3
  #undef GAPA
  #undef GAPB
  #undef EX
  #undef VRD
  #undef KRD
  #undef STEP
  #undef ENDW
  {auto rr=__builtin_amdgcn_permlane32_swap(__float_as_uint(l_reg),__float_as_uint(l_reg),false,false);l_reg=__uint_as_float(rr[0])+__uint_as_float(rr[1]);}
  if(hi==0)wsf[32+r32]=l_reg;asm volatile("s_waitcnt lgkmcnt(0)":::"memory");
  float rli[16];
  #pragma unroll
  for(int r=0;r<16;++r)rli[r]=__builtin_amdgcn_rcpf(wsf[32+crow(r,hi)]);
  bf16*Ow=O+(rowbase+q0+wid*QBLK)*OP+OCOL0+h*D;
  { bf16*stg=(bf16*)(shm+LDS_OST)+wid*2048;
    #pragma unroll
    for(int r=0;r<16;++r){const int orow=crow(r,hi);
      #pragma unroll
      for(int d0=0;d0<2;++d0)stg[orow*64+d0*32+r32]=__float2bfloat16(o[d0][r]*rli[r]);}
    asm volatile("s_waitcnt lgkmcnt(0)":::"memory");
    #pragma unroll
    for(int i=0;i<4;++i){const int row=i*8+(lane>>3),ch=lane&7; const u32x4 v=*(const u32x4*)(stg+row*64+ch*8); ATTN_STORE16(Ow+(long)row*OP+ch*8,v);} }
  asm volatile("s_waitcnt lgkmcnt(0)\n\ts_barrier":::"memory");
  #undef DMA_K
  #undef DMA_V
  #undef CMASK
  #undef START
  #undef RESC
  #undef ROT
}
constexpr int ATTN_LDS_BYTES=LDS_BYTES;
struct AttnTensors { const bf16* Q; const bf16* K; const bf16* V; bf16* O; };
struct AttnUnit { int b; int h; int qb; };
struct StaticOrder {
  int vcu,per;
  __device__ __forceinline__ explicit StaticOrder(int grid,int block):vcu((grid%8==0)?(block%8)*(grid/8)+block/8:block),per((1024+grid-1)/grid){}
  __device__ __forceinline__ bool next(int i,AttnUnit&u)const{ const int id=vcu*per+i; if(i>=per||id>=1024)return false; u.b=id>>7; u.h=(id>>4)&7; u.qb=id&15; return true; }
  __device__ __forceinline__ void a_ready(const AttnUnit&)const{}
  __device__ __forceinline__ void done(const AttnUnit&)const{}
};
template<class Sched,int THRL=8> __device__ __forceinline__ void attn_phase(char*lds,const AttnTensors&T,const Sched&S){
  AttnUnit u;
  for(int i=0;S.next(i,u);++i){ S.a_ready(u); attn_unit<THRL>(u.b,u.h,u.qb,T.Q,T.K,T.V,T.O,lds); S.done(u); }
}
#undef SBAR
#undef WAIT_BAR
}
#include <hip/hip_cooperative_groups.h>
namespace cg = cooperative_groups;

#define GAS __attribute__((address_space(1)))
#define LAS __attribute__((address_space(3)))
typedef unsigned short bf16;
typedef unsigned v4u __attribute__((ext_vector_type(4)));
typedef unsigned v2u __attribute__((ext_vector_type(2)));
typedef float f32x4 __attribute__((ext_vector_type(4)));
typedef float f32x16 __attribute__((ext_vector_type(16)));
typedef short bf16x8 __attribute__((ext_vector_type(8)));
#define LDS_WAIT() asm volatile("s_waitcnt lgkmcnt(0)" ::: "memory")

constexpr int NWAVES = 8;
constexpr int NB = 8, SEQL = 4096, DMODEL = 1024, CTXL = 256, DIN = 2816, DFF = 4096;
constexpr int MLAT = NB * SEQL, MCTX = NB * CTXL, MALL = MLAT + MCTX;
constexpr int NCH = 34;
constexpr float RMS_EPS = 1e-6f;

constexpr size_t KiB = 1024, MiB = 1u << 20;
constexpr size_t WS_ROWSS = 0, WS_BIAS2 = 512 * KiB, WS_BAR = 1 * MiB, BAR_BYTES = 16 * KiB, WS_MOD = WS_BAR + BAR_BYTES, ZERO_BYTES = BAR_BYTES + 224 * KiB;
constexpr size_t WS_WIN = 2 * MiB, WS_WOUT = 8 * MiB, WS_W1 = 10 * MiB, WS_W2 = 18 * MiB;
constexpr size_t WS_H = 32 * MiB;
constexpr size_t WS_U = 32 * MiB;
constexpr size_t WS_MIX = 32 * MiB;
constexpr size_t WS_A2 = 96 * MiB;
constexpr size_t WS_HB = 168 * MiB;
constexpr size_t WS_RQ = 168 * MiB, WS_RK = 200 * MiB, WS_RV = 234 * MiB, WS_RG = 268 * MiB, WS_AQ = 300 * MiB, WS_KB = 332 * MiB, WS_VB = 341 * MiB, WS_S = 350 * MiB;
constexpr size_t WS_D1 = 424 * MiB;
constexpr size_t WS_END = 488 * MiB;
constexpr size_t WS_PROBE = 1 * MiB + 512 * KiB;
constexpr size_t WS_ROWSS2 = 128 * KiB, WS_CNT2 = 768 * KiB;
static_assert(WS_U + (size_t)NB * 4 * NCH * 2 * 65536 <= WS_HB && WS_S + (size_t)NB * 4 * 32 * 2 * 32768 <= WS_END && WS_VB + (size_t)NB * 4352 * 128 * 2 <= WS_S, "d_ws map");

constexpr int LDS_BYTES = 147456;

__device__ __forceinline__ float wave_sum(float v) {
#pragma unroll
    for (int o = 1; o < 64; o <<= 1) v += __shfl_xor(v, o);
    return v;
}
typedef float f32x2_t_ __attribute__((ext_vector_type(2))); typedef __bf16 bf16x2_t_ __attribute__((ext_vector_type(2)));
__device__ __forceinline__ unsigned pk2(float lo, float hi) { f32x2_t_ v = {lo, hi}; return __builtin_bit_cast(unsigned, __builtin_convertvector(v, bf16x2_t_)); }
__device__ __forceinline__ unsigned f2bf(float f) { return pk2(f, 0.f) & 0xffffu; }
__device__ __forceinline__ float bf2f(unsigned short h) { return __builtin_bit_cast(float, (unsigned)h << 16); }

__host__ __device__ __forceinline__ int in_rowmap(int o) {
    const int tile = o >> 8, w = o & 255;
    if (tile < 4) { const int hl = w >> 7, d = w & 127; return tile * 256 + 128 * (d >> 6) + 32 * (2 * hl + ((d & 63) >> 5)) + (d & 31); }
    if (tile < 8) return o;
    const int hl = w >> 6, d = w & 63; return tile * 256 + 128 * (d >> 5) + 32 * hl + (d & 31);
}
template <bool PERMUTE> __device__ __forceinline__ void p0_transpose_item(const float* W, int K, int N, bf16* WT, LAS float* scr, int item, int lane) {
    const int nblk = N / 32, kb = item / nblk, nb = item % nblk, k0 = 64 * kb, n0 = 32 * nb;
    float tv[32];
#pragma unroll
    for (int i = 0; i < 32; ++i) tv[i] = __builtin_nontemporal_load(W + (size_t)(k0 + 2 * i + (lane >> 5)) * N + n0 + (lane & 31));
#pragma unroll
    for (int i = 0; i < 32; ++i) scr[(2 * i + (lane >> 5)) * 33 + (lane & 31)] = tv[i];
    LDS_WAIT(); asm volatile("" ::: "memory");
    const int c = lane & 7; const int r0 = PERMUTE ? in_rowmap(n0) : n0;
#pragma unroll
    for (int j = 0; j < 4; ++j) { const int n = (lane >> 3) + 8 * j; const LAS float* s = scr + (8 * c) * 33 + n;
        v4u o; o.x = pk2(s[0 * 33], s[1 * 33]); o.y = pk2(s[2 * 33], s[3 * 33]); o.z = pk2(s[4 * 33], s[5 * 33]); o.w = pk2(s[6 * 33], s[7 * 33]);
        *(GAS v4u*)(WT + (size_t)(r0 + n) * K + k0 + 8 * c) = o; }
    LDS_WAIT(); asm volatile("" ::: "memory");
}

__device__ __forceinline__ int sw_off(int r, int c) { return r * 256 + ((((c >> 3) ^ (r & 15)) << 4) | ((c & 7) << 1)); }
template <int NT> __device__ __forceinline__ void lds_mma(f32x16 (&acc)[NT], const LAS unsigned char* A, int arow0, const LAS unsigned char* B, int brow0, int lane) {
    const int r32 = lane & 31, hi = lane >> 5, sw = r32 & 15;
    const LAS unsigned char* ap = A + (arow0 + r32) * 256; const LAS unsigned char* bp = B + (brow0 + r32) * 256;
#pragma unroll
    for (int k0 = 0; k0 < 8; ++k0) { const int ch = ((2 * k0 + hi) ^ sw) << 4;
        const bf16x8 a = *(const LAS bf16x8*)(ap + ch);
#pragma unroll
        for (int nt = 0; nt < NT; ++nt) { const bf16x8 b = *(const LAS bf16x8*)(bp + nt * 32 * 256 + ch); acc[nt] = __builtin_amdgcn_mfma_f32_32x32x16_bf16(a, b, acc[nt], 0, 0, 0); } }
}
__device__ __forceinline__ int imgb_off(int row, int ch) { return 256 * row + 16 * (ch ^ (((row & 3) << 2) | ((row >> 2) & 3))); }
__device__ __forceinline__ bf16x8 frag_row(const LAS unsigned char* img, int row0, int lane, int s) { return *(const LAS bf16x8*)(img + imgb_off(row0 + (lane & 31), 2 * s + (lane >> 5))); }
typedef short v4i16_t __attribute__((ext_vector_type(4)));
__device__ __forceinline__ bf16x8 frag_tr(const LAS unsigned char* img, int c, int lane, int ks) {
    const int h = lane >> 5, blk = (lane >> 4) & 1, q = (lane & 15) >> 2, p = lane & 3, r0 = 16 * ks + 8 * h + q, ch = 4 * c + 2 * blk + (p >> 1);
    const v4i16_t lo = __builtin_amdgcn_ds_read_tr16_b64_v4i16((LAS v4i16_t*)(img + imgb_off(r0, ch) + 8 * (p & 1)));
    const v4i16_t hi = __builtin_amdgcn_ds_read_tr16_b64_v4i16((LAS v4i16_t*)(img + imgb_off(r0 + 4, ch) + 8 * (p & 1)));
    return (bf16x8){lo[0], lo[1], lo[2], lo[3], hi[0], hi[1], hi[2], hi[3]};
}
__device__ __forceinline__ bf16x8 frag16_row(const LAS unsigned char* img, int rb, int lane, int s) { return *(const LAS bf16x8*)(img + imgb_off((lane & 15) + 16 * rb, 4 * s + (lane >> 4))); }
__device__ __forceinline__ bf16x8 frag16_tr_perm(const LAS unsigned char* img, int c, int lane, int s) {
    const int g = lane >> 4, q = (lane & 15) >> 2, p = lane & 3, r0 = 32 * s + 4 * g + q, ch = 2 * c + (p >> 1);
    const v4i16_t lo = __builtin_amdgcn_ds_read_tr16_b64_v4i16((LAS v4i16_t*)(img + imgb_off(r0, ch) + 8 * (p & 1)));
    const v4i16_t hi = __builtin_amdgcn_ds_read_tr16_b64_v4i16((LAS v4i16_t*)(img + imgb_off(r0 + 16, ch) + 8 * (p & 1)));
    return (bf16x8){lo[0], lo[1], lo[2], lo[3], hi[0], hi[1], hi[2], hi[3]};
}
__device__ __forceinline__ int crow16(int r, int hi) { return (r & 3) + 8 * (r >> 2) + 4 * hi; }
__device__ __forceinline__ void stage_copy(LAS unsigned char* dst, const bf16* src, int pitch, int tid) {
#pragma unroll
    for (int i = 0; i < 4; ++i) { const int idx = tid + i * 512, r = idx >> 4, ch = idx & 15;
        const v4u v = *(const GAS v4u*)(src + (size_t)r * pitch + ch * 8); *(LAS v4u*)(dst + r * 256 + ((ch ^ (r & 15)) << 4)) = v; }
}
template <bool TWO> __device__ __forceinline__ void stage_transpose(LAS unsigned char* dst, LAS unsigned char* dst2, const bf16* src, int pitch, int tid, float l2a, float offa, float l2b, float offb, bool weighted) {
#pragma unroll
    for (int i = 0; i < 4; ++i) { const int idx = tid + i * 512, r = idx >> 4, ch = idx & 15;
        const v4u v = *(const GAS v4u*)(src + (size_t)r * pitch + ch * 8);
        const float wa = weighted ? __builtin_amdgcn_exp2f(l2a * ((float)r + offa)) : 1.0f;
        const float wb = TWO ? __builtin_amdgcn_exp2f(l2b * ((float)r + offb)) : 1.0f;
        const unsigned wv[4] = {v.x, v.y, v.z, v.w};
#pragma unroll
        for (int e = 0; e < 8; ++e) { const unsigned short hb = (unsigned short)((wv[e >> 1] >> ((e & 1) * 16)) & 0xffffu); const int c = ch * 8 + e;
            if (weighted) { const float f = bf2f(hb); *(LAS unsigned short*)(dst + sw_off(c, r)) = (unsigned short)f2bf(f * wa); if (TWO) *(LAS unsigned short*)(dst2 + sw_off(c, r)) = (unsigned short)f2bf(f * wb); }
            else *(LAS unsigned short*)(dst + sw_off(c, r)) = hb; } }
}

#define RLX_AGENT __ATOMIC_RELAXED, __HIP_MEMORY_SCOPE_AGENT
#define XB_TMO      128
#define XB_XCNT(j)  (256  + 64 * (j))
#define XB_XSUB(j)  (1280 + 64 * (j))
#define XB_XGEN(j)  (2304 + 64 * (j))
#define XB_TOP      3328
#define XB_TOPGEN   3392
#define XCD_BAR_WORDS 3456
#define XB_SPIN_CAP (1u << 18)

__device__ __forceinline__ unsigned xb_ld(unsigned* p)              { return __hip_atomic_load(p, __ATOMIC_RELAXED, __HIP_MEMORY_SCOPE_AGENT); }
__device__ __forceinline__ unsigned xb_add(unsigned* p, unsigned v) { return __hip_atomic_fetch_add(p, v, __ATOMIC_RELAXED, __HIP_MEMORY_SCOPE_AGENT); }
__device__ __forceinline__ unsigned xb_xcc_id() { return (unsigned)__builtin_amdgcn_s_getreg((3 << 11) | 20) & 0xFu; }
#define XB_SPIN(cond, bar) do { unsigned _sp = 0; while (cond) { __builtin_amdgcn_s_sleep(1); \
    if ((++_sp & 255u) == 0u) { if (xb_ld(&(bar)[XB_TMO])) break; if (_sp > XB_SPIN_CAP) { atomicAdd(&(bar)[XB_TMO], 1u); break; } } } } while (0)

struct XcdBarrier {
    unsigned* bar; unsigned x;
    volatile LAS unsigned* st;
};

__device__ __forceinline__ XcdBarrier xcd_barrier_post(unsigned* bar, volatile LAS unsigned* st) {
    XcdBarrier b; b.bar = bar; b.x = xb_xcc_id(); b.st = st;
    if (threadIdx.x == 0) (void)xb_add(&bar[XB_XCNT(b.x)], 1u);
    return b;
}
__device__ __forceinline__ void xcd_barrier_complete(unsigned* bar, unsigned x, unsigned& nloc, unsigned& nx) {
    const unsigned G = gridDim.x * gridDim.y * gridDim.z;
    unsigned sum, cnt, mine, sp = 0u;
    for (;;) {
        sum = 0u; cnt = 0u; mine = 0u;
#pragma unroll
        for (unsigned j = 0; j < 16; ++j) { const unsigned c = xb_ld(&bar[XB_XCNT(j)]); sum += c; cnt += (c > 0u) ? 1u : 0u; mine = (j == x) ? c : mine; }
        if (sum == G) break;
        __builtin_amdgcn_s_sleep(1);
        if ((++sp & 255u) == 0u) { if (xb_ld(&bar[XB_TMO])) break; if (sp > XB_SPIN_CAP) { atomicAdd(&bar[XB_TMO], 1u); break; } }
    }
    nloc = mine > 0u ? mine : 1u; nx = cnt > 0u ? cnt : 1u;
}

__device__ __forceinline__ void xcd_barrier(const XcdBarrier& b) {
    asm volatile("s_waitcnt vmcnt(0)" ::: "memory");
    __syncthreads();
    if (threadIdx.x == 0) {
        unsigned* bar = b.bar;
        __builtin_amdgcn_s_waitcnt(0);
        unsigned nloc = b.st[0], nx = b.st[1];
        if (nloc == 0u) { xcd_barrier_complete(bar, b.x, nloc, nx); b.st[0] = nloc; b.st[1] = nx; }
        const unsigned old = xb_add(&bar[XB_XSUB(b.x)], 1u);
        const unsigned gen = old / nloc;
        if (old + 1u == (gen + 1u) * nloc) {
            __builtin_amdgcn_fence(__ATOMIC_RELEASE, "agent");
            asm volatile("s_waitcnt vmcnt(0)" ::: "memory");
            const unsigned og = xb_add(&bar[XB_TOP], 1u);
            const unsigned tg = og / nx;
            if (og + 1u == (tg + 1u) * nx) xb_add(&bar[XB_TOPGEN], 1u);
            else XB_SPIN(xb_ld(&bar[XB_TOPGEN]) == tg, bar);
            __builtin_amdgcn_fence(__ATOMIC_ACQUIRE, "agent");
            xb_add(&bar[XB_XGEN(b.x)], 1u);
            asm volatile("s_waitcnt vmcnt(0)" ::: "memory");
        } else {
            XB_SPIN(xb_ld(&bar[XB_XGEN(b.x)]) == gen, bar);
            __builtin_amdgcn_fence(__ATOMIC_ACQUIRE, "agent");
            asm volatile("s_waitcnt vmcnt(0)" ::: "memory");
        }
    }
    __syncthreads();
}
#ifndef REP_PRE
#define REP_PRE 1
#endif
#ifndef REP_P2
#define REP_P2 1
#endif
#ifndef REP_RET
#define REP_RET 1
#endif
#ifndef REP_ATT
#define REP_ATT 1
#endif
#ifndef REP_P7
#define REP_P7 1
#endif
#ifndef REP_P3
#define REP_P3 1
#endif
#ifndef REP_P5A
#define REP_P5A 1
#endif
#ifndef REP_P0
#define REP_P0 1
#endif
#ifndef REP_P6
#define REP_P6 1
#endif
#ifndef REP_P8
#define REP_P8 1
#endif
struct Args { const float* in[17]; float* out; unsigned char* ws; };
#define CAS __attribute__((address_space(4)))
#define PHASE_PTRS() \
    const CAS unsigned char* kp_ = (const CAS unsigned char*)__builtin_amdgcn_kernarg_segment_ptr(); asm volatile("" : "+s"(kp_)); \
    const CAS Args* ka_ = (const CAS Args*)kp_; unsigned char* ws = ka_->ws; (void)ws; \
    const float *x = ka_->in[0], *cvec = ka_->in[1], *ctxp = ka_->in[2], *c_ctx = ka_->in[3], *w_mod = ka_->in[4], *b_mod = ka_->in[5], *n1g = ka_->in[6], *n2g = ka_->in[7], \
                *w_in = ka_->in[8], *w_out = ka_->in[9], *ret_rate = ka_->in[10], *ret_gn = ka_->in[11], *qng = ka_->in[12], *kng = ka_->in[13], *w_ff1 = ka_->in[14], *w_ff2 = ka_->in[15], *fng = ka_->in[16]; \
    float* out = ka_->out; \
    float* rowss = (float*)(ws + WS_ROWSS); float* MOD = (float*)(ws + WS_MOD); float* BIAS2 = (float*)(ws + WS_BIAS2); \
    bf16 *Win_t = (bf16*)(ws + WS_WIN), *Wout_t = (bf16*)(ws + WS_WOUT), *W1_t = (bf16*)(ws + WS_W1), *W2_t = (bf16*)(ws + WS_W2); \
    bf16 *H = (bf16*)(ws + WS_H), *MIX = (bf16*)(ws + WS_MIX), *A2 = (bf16*)(ws + WS_A2), *HB = (bf16*)(ws + WS_HB); \
    bf16 *RQ = (bf16*)(ws + WS_RQ), *RK = (bf16*)(ws + WS_RK), *RV = (bf16*)(ws + WS_RV), *RG = (bf16*)(ws + WS_RG), *AQ = (bf16*)(ws + WS_AQ), *KB = (bf16*)(ws + WS_KB), *VB = (bf16*)(ws + WS_VB), *SB = (bf16*)(ws + WS_S); \
    float* rowss2 = (float*)(ws + WS_ROWSS2); unsigned* cnt2 = (unsigned*)(ws + WS_CNT2); bf16* D1 = (bf16*)(ws + WS_D1); (void)rowss2; (void)cnt2; (void)D1; \
    float* U = (float*)(ws + WS_U); \
    (void)x; (void)cvec; (void)ctxp; (void)c_ctx; (void)w_mod; (void)b_mod; (void)n1g; (void)n2g; (void)w_in; (void)w_out; (void)ret_rate; (void)ret_gn; (void)qng; (void)kng; (void)w_ff1; (void)w_ff2; (void)fng; (void)out; \
    (void)rowss; (void)MOD; (void)BIAS2; (void)Win_t; (void)Wout_t; (void)W1_t; (void)W2_t; (void)H; (void)MIX; (void)A2; (void)HB; (void)RQ; (void)RK; (void)RV; (void)RG; (void)AQ; (void)KB; (void)VB; (void)SB; (void)U;


__global__ void __launch_bounds__(NWAVES * 64, 2) fwd_megakernel(Args args) {
    extern __shared__ __attribute__((aligned(16))) unsigned char lds_raw[];
    LAS unsigned char* lds = (LAS unsigned char*)lds_raw;
    cg::grid_group grid = cg::this_grid();
    if (args.ws == nullptr) grid.sync();
    { volatile LAS unsigned* st0 = (volatile LAS unsigned*)(lds + LDS_BYTES - 64); if (threadIdx.x < 16) st0[threadIdx.x] = 0u; }
    __syncthreads();
    const XcdBarrier gbar = xcd_barrier_post((unsigned*)(args.ws + WS_BAR), (volatile LAS unsigned*)(lds + LDS_BYTES - 64));
#define GRID_SYNC() xcd_barrier(gbar)
    const int tid = threadIdx.x, lane = tid & 63, wave = __builtin_amdgcn_readfirstlane(tid >> 6);
    const int G = gridDim.x, bx = blockIdx.x, vcu = (G % 8 == 0) ? (bx % 8) * (G / 8) + bx / 8 : bx;
    const int gw = vcu * NWAVES + wave, NGW = G * NWAVES;

    for (int rep_ = 0; rep_ < REP_PRE; ++rep_) {
    for (int rp0_ = 0; rp0_ < REP_P0; ++rp0_) {
#ifndef SKIP_P0
    {
        PHASE_PTRS();
        for (int i = bx * 512 + tid; i < MLAT; i += G * 512) { rowss[i] = 0.f; rowss2[i] = 0.f; if (i < 128 * 64) cnt2[i] = 0u; }
#if REP_P6 > 1 || REP_P8 > 1
        for (int i = bx * 512 + tid; i < MLAT; i += G * 512) { ((float*)(ws + WS_PROBE))[i] = 0.f; ((float*)(ws + WS_PROBE))[MLAT + i] = 0.f; if (i < 128 * 64) ((unsigned*)(ws + WS_PROBE))[2 * MLAT + i] = 0u; }
#endif
        if (vcu < 192) {
            const int cgp = vcu % 96, kh = vcu / 96;
            LAS float* cact = (LAS float*)(lds + 73728);
            LAS float* red = (LAS float*)(lds + 73728 + 36864);
            const int col = cgp * 64 + lane; float wv[64];
#pragma unroll
            for (int i = 0; i < 64; ++i) wv[i] = __builtin_nontemporal_load(w_mod + (size_t)(kh * 512 + wave * 64 + i) * 6144 + col);
            for (int i = tid; i < 9 * 512; i += 512) { const int b = i >> 9, k = kh * 512 + (i & 511); const float v = (b < 8) ? cvec[b * 1024 + k] : c_ctx[k]; cact[i] = v * __builtin_amdgcn_rcpf(1.0f + __builtin_amdgcn_exp2f(-v * 1.4426950408889634f)); }
            __syncthreads();
            float a9[9];
#pragma unroll
            for (int b = 0; b < 9; ++b) a9[b] = 0.f;
#pragma unroll
            for (int i = 0; i < 64; i += 4)
#pragma unroll
                for (int b = 0; b < 9; ++b) { const f32x4 cv = *(const LAS f32x4*)(cact + b * 512 + wave * 64 + i); a9[b] += cv[0] * wv[i] + cv[1] * wv[i + 1] + cv[2] * wv[i + 2] + cv[3] * wv[i + 3]; }
#pragma unroll
            for (int b = 0; b < 9; ++b) red[(wave * 9 + b) * 64 + lane] = a9[b];
            __syncthreads();
            for (int i = tid; i < 576; i += 512) { const int b = i >> 6, l = i & 63; float s = kh ? 0.f : b_mod[cgp * 64 + l];
#pragma unroll
                for (int w = 0; w < 8; ++w) s += red[(w * 9 + b) * 64 + l];
                atomicAdd(MOD + b * 6144 + cgp * 64 + l, s); }
            __syncthreads();
        }
        LAS float* scr = (LAS float*)(lds + wave * 9216);
        constexpr int I_IN = (DMODEL / 64) * (DIN / 32);
        for (int it = gw; it < I_IN; it += NGW) p0_transpose_item<true>(w_in, DMODEL, DIN, Win_t, scr, it, lane);
    }
#endif
    }
    GRID_SYNC();

#ifndef SKIP_P1
    {
        PHASE_PTRS();
        {
            const int rpw = (MALL + NGW - 1) / NGW, m0 = gw * rpw, m1 = (m0 + rpw < MALL) ? m0 + rpw : MALL;
            f32x4 ca[4], cb[4], v[4], nx[4], nx2[4]; int cur = -1;
#define P1_SRC(m_) (((m_) < MLAT) ? x + (size_t)(m_) * 1024 : ctxp + (size_t)((m_) - MLAT) * 1024)
            if (m0 < m1) { const float* src = P1_SRC(m0);
#pragma unroll
                for (int j = 0; j < 4; ++j) nx[j] = __builtin_nontemporal_load((const GAS f32x4*)(src + 256 * j + 4 * lane)); }
            if (m0 + 1 < m1) { const float* src = P1_SRC(m0 + 1);
#pragma unroll
                for (int j = 0; j < 4; ++j) nx2[j] = __builtin_nontemporal_load((const GAS f32x4*)(src + 256 * j + 4 * lane)); }
            for (int m = m0; m < m1; ++m) {
#pragma unroll
                for (int j = 0; j < 4; ++j) { v[j] = nx[j]; nx[j] = nx2[j]; }
                if (m + 2 < m1) { const float* src = P1_SRC(m + 2);
#pragma unroll
                    for (int j = 0; j < 4; ++j) nx2[j] = __builtin_nontemporal_load((const GAS f32x4*)(src + 256 * j + 4 * lane)); }
                const int bidx = (m < MLAT) ? (m >> 12) : 8;
                if (bidx != cur) { cur = bidx; const float* mb = MOD + (size_t)bidx * 6144;
#pragma unroll
                    for (int j = 0; j < 4; ++j) { const int k = 256 * j + 4 * lane; const f32x4 g = *(const f32x4*)(n1g + k), sh = *(const f32x4*)(mb + k), sc = *(const f32x4*)(mb + 1024 + k); ca[j] = g * (sc + 1.0f); cb[j] = sh; } }
                float s = 0.f;
#pragma unroll
                for (int j = 0; j < 4; ++j) s += (v[j][0] * v[j][0] + v[j][1] * v[j][1]) + (v[j][2] * v[j][2] + v[j][3] * v[j][3]);
                const float rstd = 1.0f / sqrtf(wave_sum(s) * (1.0f / 1024.0f) + RMS_EPS);
#pragma unroll
                for (int j = 0; j < 4; ++j) { const f32x4 y = (v[j] * rstd) * ca[j] + cb[j]; v2u o; o.x = pk2(y[0], y[1]); o.y = pk2(y[2], y[3]);
                    *(GAS v2u*)(H + (size_t)m * 1024 + 256 * j + 4 * lane) = o; }
            }
        }
    }
#endif
    if (rep_ + 1 < REP_PRE) GRID_SYNC(); }
    GRID_SYNC();

    for (int rep_ = 0; rep_ < REP_P2; ++rep_) {
#ifndef SKIP_P2
    {
        PHASE_PTRS();
        pg8::Gemm g{H, Win_t, MALL, DIN, DMODEL}; pg8::StaticOrder S; S.init(MALL, DIN, G, bx);
        pg8::EpiIn E{RQ, RK, RV, RG, AQ, KB, VB, qng, kng};
        pg8::gemm_phase<pg8::EpiIn, pg8::StaticOrder, PG8_ALIGN, PG8_SP2>(lds, g, S, E);
    }
#endif
    }
    GRID_SYNC();

    {
    const attn_body::StaticOrder AS(G, bx); const int pslot = vcu & 1, ahalf = AS.per / 2;
#pragma unroll
    for (int slot = 0; slot < 2; ++slot) {
    if (slot == pslot) {
#ifndef SKIP_P3
    {
        PHASE_PTRS();
        for (int rp3_ = 0; rp3_ < REP_P3; ++rp3_)
        for (int task = vcu; task < 256; task += G) {
            int tid = threadIdx.x; asm volatile("" : "+v"(tid)); const int lane = tid & 63;
            const int bh = task >> 3, dir = (task >> 2) & 1, vq = task & 3, b = bh >> 2, h = bh & 3;
            const float lg2 = log1pf(-expf(ret_rate[dir * 4 + h])) * 1.4426950408889634f; const float Gd = __builtin_amdgcn_exp2f(lg2 * 128.0f);
            const int vr = tid >> 2, vch = tid & 3;
            const float wv = __builtin_amdgcn_exp2f(lg2 * (float)(dir ? vr : 127 - vr));
            v4u kregA[4], vregA, kregB[4], vregB;
            auto row0_of = [&](int s_) -> size_t { if (s_ < 2) { const int q = dir ? 1 - s_ : s_; return (size_t)MLAT + b * CTXL + q * 128; } const int c = dir ? 33 - s_ : s_ - 2; return (size_t)b * SEQL + c * 128; };
#define P3_LOAD(KR, VR, s_) do { const size_t r0_ = row0_of(s_); _Pragma("unroll") for (int i = 0; i < 4; ++i) { const int idx = tid + i * 512; KR[i] = *(const GAS v4u*)(RK + (r0_ + (idx >> 4)) * 512 + h * 128 + (idx & 15) * 8); } \
                VR = *(const GAS v4u*)(RV + (r0_ + vr) * 512 + h * 128 + vq * 32 + vch * 8); } while (0)
#define P3_LBAR() asm volatile("s_waitcnt lgkmcnt(0)\n\ts_barrier" ::: "memory")
#define P3_STEP(KR, VR, s_) do { \
                LAS unsigned char* Kimg = lds + ((s_) & 1) * 65536; LAS unsigned char* Vimg = Kimg + 32768; \
                _Pragma("unroll") for (int i = 0; i < 4; ++i) { const int idx = tid + i * 512; *(LAS v4u*)(Kimg + imgb_off(idx >> 4, idx & 15)) = KR[i]; } \
                { const unsigned vu[4] = {VR.x, VR.y, VR.z, VR.w}; v4u o; \
                  o.x = pk2(__builtin_bit_cast(float, vu[0] << 16) * wv, __builtin_bit_cast(float, vu[0] & 0xffff0000u) * wv); o.y = pk2(__builtin_bit_cast(float, vu[1] << 16) * wv, __builtin_bit_cast(float, vu[1] & 0xffff0000u) * wv); \
                  o.z = pk2(__builtin_bit_cast(float, vu[2] << 16) * wv, __builtin_bit_cast(float, vu[2] & 0xffff0000u) * wv); o.w = pk2(__builtin_bit_cast(float, vu[3] << 16) * wv, __builtin_bit_cast(float, vu[3] & 0xffff0000u) * wv); \
                  *(LAS v4u*)(Vimg + imgb_off(vr, vch)) = o; } \
                if ((s_) + 2 < 34) P3_LOAD(KR, VR, (s_) + 2); \
                P3_LBAR(); \
                if (wave < 4) { \
                    const int r32 = lane & 31, hi = lane >> 5; \
                    if ((s_) >= 2) { const int c = dir ? 33 - (s_) : (s_) - 2; bf16* sp = SB + ((size_t)(bh * 32 + c) * 2 + dir) * 16384 + (size_t)(vq * 32) * 128 + wave * 32 + r32; \
                        _Pragma("unroll") for (int r = 0; r < 16; ++r) sp[crow16(r, hi) * 128] = (bf16)f2bf(acc[r]); } \
                    if ((s_) < 33) { \
                        _Pragma("unroll") for (int r = 0; r < 16; ++r) acc[r] *= Gd; \
                        f32x16 acc2 = f32x16{};     \
                        _Pragma("unroll") for (int ks = 0; ks < 8; ks += 2) { acc = __builtin_amdgcn_mfma_f32_32x32x16_bf16(frag_tr(Vimg, 0, lane, ks), frag_tr(Kimg, wave, lane, ks), acc, 0, 0, 0); \
                            acc2 = __builtin_amdgcn_mfma_f32_32x32x16_bf16(frag_tr(Vimg, 0, lane, ks + 1), frag_tr(Kimg, wave, lane, ks + 1), acc2, 0, 0, 0); } \
                        _Pragma("unroll") for (int r = 0; r < 16; ++r) acc[r] += acc2[r]; \
                    } \
                } } while (0)
            P3_LOAD(kregA, vregA, 0); P3_LOAD(kregB, vregB, 1);
            f32x16 acc = f32x16{};
            for (int s_ = 0; s_ < 34; s_ += 2) { P3_STEP(kregA, vregA, s_); P3_STEP(kregB, vregB, s_ + 1); }
            P3_LBAR();
#undef P3_LOAD
#undef P3_STEP
#undef P3_LBAR
        }
    }
#endif
    {
        PHASE_PTRS();
        int tid = threadIdx.x; asm volatile("" : "+v"(tid)); const int lane = tid & 63;
        LAS float* scr = (LAS float*)(lds + wave * 9216);
        constexpr int I_OUT = (DMODEL / 64) * (DMODEL / 32), I_1 = (DMODEL / 64) * (DFF / 32), I_2 = (DFF / 64) * (DMODEL / 32);
        for (int it = gw; it < I_OUT + I_1 + I_2; it += NGW) {
            int r = it;
            if (r < I_OUT) { p0_transpose_item<false>(w_out, DMODEL, DMODEL, Wout_t, scr, r, lane); continue; } r -= I_OUT;
            if (r < I_1) { p0_transpose_item<false>(w_ff1, DMODEL, DFF, W1_t, scr, r, lane); continue; } r -= I_1;
            p0_transpose_item<false>(w_ff2, DFF, DMODEL, W2_t, scr, r, lane);
        }
        __syncthreads();
    }
    }
    if (slot == 0) {
#ifndef SKIP_P5b
    {
        PHASE_PTRS();
        attn_body::AttnUnit u;
        for (int au = 0; au < ahalf && AS.next(au, u); ++au) attn_body::attn_unit<8>(u.b, u.h, u.qb, (const attn_body::bf16*)AQ, (const attn_body::bf16*)KB, (const attn_body::bf16*)VB, (attn_body::bf16*)MIX, (char*)lds_raw);
    }
#endif
    }
    }
    }
    GRID_SYNC();

    {
    const attn_body::StaticOrder AS(G, bx); const int pslot = vcu & 1, ahalf = AS.per / 2;
#pragma unroll
    for (int slot = 0; slot < 2; ++slot) {
    if (slot == pslot) {
#ifndef SKIP_P5a
    {
        PHASE_PTRS();
        LAS unsigned char* Ks = lds; LAS unsigned char* Vs = lds + 32768; LAS unsigned char* Fs = lds + 65536; LAS unsigned char* Bs = lds + 98304;
#define LBAR() asm volatile("s_waitcnt lgkmcnt(0)\n\ts_barrier" ::: "memory")
#define P5_LOAD(t_) do { const int bh_ = (t_) >> 5, c_ = (t_) & 31; const size_t r0_ = (size_t)(bh_ >> 2) * SEQL + c_ * 128; const int h_ = bh_ & 3; \
        _Pragma("unroll") for (int i = 0; i < 4; ++i) { const int idx = ptid + i * 512, r = idx >> 4, ch = idx & 15; const size_t go = (r0_ + r) * 512 + h_ * 128 + ch * 8; \
            kr_[i] = *(const GAS v4u*)(RK + go); vr_[i] = *(const GAS v4u*)(RV + go); fr_[i] = *(const GAS v4u*)(SB + ((size_t)(t_) * 2 + 0) * 16384 + r * 128 + ch * 8); br_[i] = *(const GAS v4u*)(SB + ((size_t)(t_) * 2 + 1) * 16384 + r * 128 + ch * 8); } \
        _Pragma("unroll") for (int s4 = 0; s4 < 4; ++s4) qn_[s4] = *(const GAS v4u*)(RQ + (r0_ + 16 * wave + (ptid & 15)) * 512 + h_ * 128 + 32 * s4 + 8 * ((ptid & 63) >> 4)); } while (0)
        v4u kr_[4], vr_[4], fr_[4], br_[4], qn_[4];
        { const int ptid = threadIdx.x; if (vcu < NB * 4 * 32) P5_LOAD(vcu); }
        for (int rp5_ = 0; rp5_ < REP_P5A; ++rp5_)
        for (int task = vcu; task < NB * 4 * 32; task += G) {
            const int bh = task >> 5, c = task & 31, b = bh >> 2, h = bh & 3;
            int tid = threadIdx.x; asm volatile("" : "+v"(tid)); const int lane = tid & 63; const int il = lane & 15, g4 = lane >> 4;
            const float lgf = log1pf(-expf(ret_rate[h])) * 1.4426950408889634f, lgb = log1pf(-expf(ret_rate[4 + h])) * 1.4426950408889634f;
            const size_t row0 = (size_t)b * SEQL + c * 128; const int irow = 16 * wave + il;
#pragma unroll
            for (int i = 0; i < 4; ++i) { const int idx = tid + i * 512, o = imgb_off(idx >> 4, idx & 15);
                *(LAS v4u*)(Ks + o) = kr_[i]; *(LAS v4u*)(Vs + o) = vr_[i]; *(LAS v4u*)(Fs + o) = fr_[i]; *(LAS v4u*)(Bs + o) = br_[i]; }
            bf16x8 qf[4];
#pragma unroll
            for (int s4 = 0; s4 < 4; ++s4) qf[s4] = __builtin_bit_cast(bf16x8, qn_[s4]);
            v2u gq[8];
#pragma unroll
            for (int vt = 0; vt < 8; ++vt) gq[vt] = *(const GAS v2u*)(RG + (row0 + irow) * 512 + h * 128 + 16 * vt + 4 * g4);
            { const int ptid = tid; const int nt_ = (task + G < NB * 4 * 32) ? task + G : vcu; P5_LOAD(nt_); }
            LBAR();
            f32x4 st[8];
#pragma unroll
            for (int t = 0; t < 8; ++t) { st[t] = (f32x4){0.f, 0.f, 0.f, 0.f};
#pragma unroll
                for (int s4 = 0; s4 < 4; ++s4) st[t] = __builtin_amdgcn_mfma_f32_16x16x32_bf16(frag16_row(Ks, t, lane, s4), qf[s4], st[t], 0, 0, 0); }
            bf16x8 pf[4];
#pragma unroll
            for (int s4 = 0; s4 < 4; ++s4) { unsigned pw[4];
#pragma unroll
                for (int hf = 0; hf < 2; ++hf) { const int t = 2 * s4 + hf; float wv[4];
#pragma unroll
                    for (int jj = 0; jj < 4; ++jj) { const int dlt = irow - (16 * t + 4 * g4 + jj); const float fd = (float)dlt; float w = __builtin_amdgcn_exp2f((dlt > 0) ? lgf * fd : -lgb * fd); w = (dlt == 0) ? 2.0f : w; wv[jj] = st[t][jj] * w; }
                    pw[2 * hf] = pk2(wv[0], wv[1]); pw[2 * hf + 1] = pk2(wv[2], wv[3]); }
                pf[s4] = __builtin_bit_cast(bf16x8, (v4u){pw[0], pw[1], pw[2], pw[3]}); }
            f32x4 ot[8];
#pragma unroll
            for (int vt = 0; vt < 8; ++vt) { ot[vt] = (f32x4){0.f, 0.f, 0.f, 0.f};
#pragma unroll
                for (int s4 = 0; s4 < 4; ++s4) ot[vt] = __builtin_amdgcn_mfma_f32_16x16x32_bf16(frag16_tr_perm(Vs, vt, lane, s4), pf[s4], ot[vt], 0, 0, 0); }
            { const float qfw = __builtin_amdgcn_exp2f(lgf * (float)(irow + 1)), qbw = __builtin_amdgcn_exp2f(lgb * (float)(128 - irow));
#pragma unroll
              for (int vt = 0; vt < 8; ++vt) { f32x4 t2 = (f32x4){0.f, 0.f, 0.f, 0.f}, t3 = (f32x4){0.f, 0.f, 0.f, 0.f};
#pragma unroll
                  for (int s4 = 0; s4 < 4; ++s4) { t2 = __builtin_amdgcn_mfma_f32_16x16x32_bf16(frag16_row(Fs, vt, lane, s4), qf[s4], t2, 0, 0, 0); t3 = __builtin_amdgcn_mfma_f32_16x16x32_bf16(frag16_row(Bs, vt, lane, s4), qf[s4], t3, 0, 0, 0); }
                  ot[vt] += t2 * qfw + t3 * qbw; } }
            { float sm = 0.f;
#pragma unroll
              for (int vt = 0; vt < 8; ++vt) sm += (ot[vt][0] + ot[vt][1]) + (ot[vt][2] + ot[vt][3]);
              sm += __shfl_xor(sm, 16); sm += __shfl_xor(sm, 32); const float mu = sm * (1.0f / 128.0f); float sq = 0.f;
#pragma unroll
              for (int vt = 0; vt < 8; ++vt) { ot[vt] = ot[vt] - mu; sq += (ot[vt][0] * ot[vt][0] + ot[vt][1] * ot[vt][1]) + (ot[vt][2] * ot[vt][2] + ot[vt][3] * ot[vt][3]); }
              sq += __shfl_xor(sq, 16); sq += __shfl_xor(sq, 32); const float rstd = 1.0f / sqrtf(sq * (1.0f / 128.0f) + RMS_EPS);
              const float* gn = ret_gn + h * 128 + 4 * g4; bf16* mp = MIX + (row0 + irow) * 1024 + h * 128 + 4 * g4;
#pragma unroll
              for (int vt = 0; vt < 8; ++vt) { const f32x4 n0 = *(const f32x4*)(gn + 16 * vt); const f32x4 a = ot[vt] * rstd * n0; const v2u gv = gq[vt];
                  v2u ov; ov.x = pk2(a[0] * __builtin_bit_cast(float, gv.x << 16), a[1] * __builtin_bit_cast(float, gv.x & 0xffff0000u)); ov.y = pk2(a[2] * __builtin_bit_cast(float, gv.y << 16), a[3] * __builtin_bit_cast(float, gv.y & 0xffff0000u));
                  *(GAS v2u*)(mp + 16 * vt) = ov; } }
            LBAR();
        }
#undef LBAR
#undef P5_LOAD
    }
#endif
    {
        PHASE_PTRS();
        int tid = threadIdx.x; asm volatile("" : "+v"(tid)); const int lane = tid & 63;
        for (int n = gw; n < DFF; n += NGW) {
            const v4u wa = *(const GAS v4u*)(W1_t + (size_t)n * 1024 + 8 * lane), wb = *(const GAS v4u*)(W1_t + (size_t)n * 1024 + 512 + 8 * lane);
            float wf[16]; const unsigned wu[8] = {wa.x, wa.y, wa.z, wa.w, wb.x, wb.y, wb.z, wb.w};
#pragma unroll
            for (int e = 0; e < 8; ++e) { wf[2 * e] = __builtin_bit_cast(float, wu[e] << 16); wf[2 * e + 1] = __builtin_bit_cast(float, wu[e] & 0xffff0000u); }
            float myv = 0.f;
#pragma unroll
            for (int b = 0; b < 8; ++b) { const float* sh2 = MOD + (size_t)b * 6144 + 3072; float s = 0.f;
#pragma unroll
                for (int hlf = 0; hlf < 2; ++hlf) { const f32x4 p = *(const f32x4*)(sh2 + 512 * hlf + 8 * lane), q = *(const f32x4*)(sh2 + 512 * hlf + 8 * lane + 4);
                    s += p[0] * wf[8 * hlf + 0] + p[1] * wf[8 * hlf + 1] + p[2] * wf[8 * hlf + 2] + p[3] * wf[8 * hlf + 3] + q[0] * wf[8 * hlf + 4] + q[1] * wf[8 * hlf + 5] + q[2] * wf[8 * hlf + 6] + q[3] * wf[8 * hlf + 7]; }
                s = wave_sum(s); if (lane == b) myv = s; }
            if (lane < 8) BIAS2[(size_t)lane * 4096 + n] = myv;
        }
    }
    }
    if (slot == 0) {
#ifndef SKIP_P5b
    {
        PHASE_PTRS();
        attn_body::AttnUnit u;
        for (int au = ahalf; AS.next(au, u); ++au) attn_body::attn_unit<8>(u.b, u.h, u.qb, (const attn_body::bf16*)AQ, (const attn_body::bf16*)KB, (const attn_body::bf16*)VB, (attn_body::bf16*)MIX, (char*)lds_raw);
    }
#endif
    }
    }
    }
    GRID_SYNC();

    for (int rep_ = 0; rep_ < REP_P6; ++rep_) {
#ifndef SKIP_P6
    {
        PHASE_PTRS();
        pg8::Gemm g{MIX, Wout_t, MLAT, DMODEL, DMODEL}; pg8::StaticOrder S; S.init(MLAT, DMODEL, G, bx);
        pg8::EpiOut E{x, D1, A2, MOD, n2g, rep_ == 0 ? rowss : (float*)(ws + WS_PROBE)};
        pg8::gemm_phase<pg8::EpiOut, pg8::StaticOrder, PG8_ALIGN, PG8_SP2>(lds, g, S, E);
    }
#endif
    }
    GRID_SYNC();

    for (int rep_ = 0; rep_ < REP_P7; ++rep_) {
#ifndef SKIP_P7
    {
        PHASE_PTRS();
        pg8::Gemm g{A2, W1_t, MLAT, DFF, DMODEL}; pg8::StaticOrder S; S.init(MLAT, DFF, G, bx);
        pg8::EpiFF1 E{HB, BIAS2, rowss};
        pg8::gemm_phase<pg8::EpiFF1, pg8::StaticOrder, PG8_ALIGN, PG8_SP2>(lds, g, S, E);
    }
#endif
    }
    GRID_SYNC();

    for (int rep_ = 0; rep_ < REP_P8; ++rep_) {
#ifndef SKIP_P8
    {
        PHASE_PTRS();
        pg8::Gemm g{HB, W2_t, MLAT, DMODEL, DFF}; pg8::StaticOrder S; S.init(MLAT, DMODEL, G, bx);
        pg8::EpiFF2N E{D1, out, MOD, fng, rep_ == 0 ? rowss2 : (float*)(ws + WS_PROBE) + MLAT, rep_ == 0 ? cnt2 : (unsigned*)(ws + WS_PROBE) + 2 * MLAT};
        pg8::gemm_phase<pg8::EpiFF2N, pg8::StaticOrder, PG8_ALIGN, PG8_SP2>(lds, g, S, E);
    }
#endif
    if (rep_ + 1 < REP_P8) GRID_SYNC(); }
}

extern "C" void kernel_launch(void* const* d_in, const int* in_sizes, int n_in, void* d_out, int out_size, void* d_ws, size_t ws_size, hipStream_t stream) {
    static int grid = 0;
    if (grid == 0) {
        if (n_in != 17 || out_size != MLAT * DMODEL || ws_size < WS_END) { fprintf(stderr, "kernel_launch: unexpected shapes (n_in %d, out %d, ws %zu); nothing launched\n", n_in, out_size, ws_size); grid = -1; return; }
        int dev = 0, cus = 0, per_cu = 0;
        if (hipGetDevice(&dev) != hipSuccess || hipDeviceGetAttribute(&cus, hipDeviceAttributeMultiprocessorCount, dev) != hipSuccess) { grid = -1; return; }
        if (hipFuncSetAttribute((const void*)fwd_megakernel, hipFuncAttributeMaxDynamicSharedMemorySize, LDS_BYTES) != hipSuccess) { fprintf(stderr, "kernel_launch: hipFuncSetAttribute failed\n"); grid = -1; return; }
        if (hipOccupancyMaxActiveBlocksPerMultiprocessor(&per_cu, (const void*)fwd_megakernel, NWAVES * 64, LDS_BYTES) != hipSuccess || per_cu < 1) { fprintf(stderr, "kernel_launch: occupancy query gave %d\n", per_cu); per_cu = 1; }
        (void)hipGetLastError();
        grid = cus - cus % 32;
        if (grid < 32) grid = cus;
    }
    if (grid < 0) return;
    if (hipMemsetAsync((char*)d_ws + WS_BAR, 0, ZERO_BYTES, stream) != hipSuccess) { fprintf(stderr, "kernel_launch: hipMemsetAsync failed\n"); return; }
    Args a{};
    for (int i = 0; i < 17; ++i) a.in[i] = (const float*)d_in[i];
    a.out = (float*)d_out; a.ws = (unsigned char*)d_ws;
    void* kargs[] = {&a};
    const hipError_t le = hipLaunchCooperativeKernel((const void*)fwd_megakernel, dim3(grid), dim3(NWAVES * 64), kargs, LDS_BYTES, stream);
    if (le != hipSuccess) fprintf(stderr, "kernel_launch: cooperative launch failed: %s (grid %d)\n", hipGetErrorName(le), grid);
}
```
